# Optimizing an MI355X kernel written in HIP

```python
import jax, jax.numpy as jnp
from jax import lax
import numpy as np

D_MODEL = 2048
BATCH = 4
SEQ = 4096
DEPTH = 1
DEC_BATCH = 1
DEC_SEQ = 16384
PAST_LEN = 128

MLA_HEADS = 8
QK_NOPE = 128
QK_ROPE = 64
V_HEAD = 128
Q_LORA = 512
KV_LORA = 512
ROPE_THETA = 10000.0
Q_BLOCK = 128
GLA_HEADS = 4
GLA_DK = 128
GLA_DV = 256
GLA_GATE_RANK = 16
GLA_GATE_NORM = 16.0
GLA_CHUNK = 64
D_FF = 4 * D_MODEL
MIX_WIDTH = MLA_HEADS * V_HEAD + GLA_HEADS * GLA_DV
EPS = 1e-6

IN_SPLITS = (Q_LORA, KV_LORA, QK_ROPE, GLA_HEADS * GLA_DK, GLA_HEADS * GLA_DK, GLA_HEADS * GLA_DV, GLA_GATE_RANK, GLA_GATE_RANK, GLA_HEADS * GLA_DV)
IN_WIDTH = sum(IN_SPLITS)

kernel_name = 'hymba_mla_gla_sandwich_encoder'


def rms_norm(x, w):
    xf = x.astype(jnp.float32)
    y = xf * lax.rsqrt(jnp.mean(xf * xf, axis=-1, keepdims=True) + EPS)
    return (y * w.astype(jnp.float32)).astype(x.dtype)


def rope_tables(L):
    inv = 1.0 / (ROPE_THETA ** (jnp.arange(0, QK_ROPE, 2, dtype=jnp.float32) / QK_ROPE))
    ang = jnp.arange(L, dtype=jnp.float32)[:, None] * inv[None, :]
    return jnp.cos(ang), jnp.sin(ang)


def apply_rope(x, cos, sin):
    xf = x.astype(jnp.float32)
    x1, x2 = xf[..., :QK_ROPE // 2], xf[..., QK_ROPE // 2:]
    return jnp.concatenate([x1 * cos - x2 * sin, x2 * cos + x1 * sin], axis=-1).astype(x.dtype)


def mla_attention(c_q, c_kv, k_rope, q_a_norm, w_q_b, kv_a_norm, w_kv_b):
    B, L, _ = c_q.shape
    cos, sin = rope_tables(L)
    q = (rms_norm(c_q, q_a_norm) @ w_q_b).reshape(B, L, MLA_HEADS, QK_NOPE + QK_ROPE)
    q_nope = q[..., :QK_NOPE]
    q_rope = apply_rope(q[..., QK_NOPE:], cos[:, None, :], sin[:, None, :])
    kv = (rms_norm(c_kv, kv_a_norm) @ w_kv_b).reshape(B, L, MLA_HEADS, QK_NOPE + V_HEAD)
    k_nope, v = kv[..., :QK_NOPE], kv[..., QK_NOPE:]
    k_pe = apply_rope(k_rope, cos, sin)
    scale = (QK_NOPE + QK_ROPE) ** -0.5
    nb = L // Q_BLOCK
    qn_blocks = q_nope.reshape(B, nb, Q_BLOCK, MLA_HEADS, QK_NOPE).transpose(1, 0, 2, 3, 4)
    qr_blocks = q_rope.reshape(B, nb, Q_BLOCK, MLA_HEADS, QK_ROPE).transpose(1, 0, 2, 3, 4)

    def attend(blk):
        qn, qr = blk
        s = jnp.einsum('bqhd,bkhd->bhqk', qn, k_nope) + jnp.einsum('bqhr,bkr->bhqk', qr, k_pe)
        p = jax.nn.softmax(s.astype(jnp.float32) * scale, axis=-1).astype(v.dtype)
        return jnp.einsum('bhqk,bkhd->bqhd', p, v)

    o = lax.map(attend, (qn_blocks, qr_blocks))
    return o.transpose(1, 0, 2, 3, 4).reshape(B, L, MLA_HEADS * V_HEAD)


def gla_scan(q, k, v, log_g):
    B, L, H, DK = q.shape
    DV = v.shape[-1]
    N = L // GLA_CHUNK

    def to_chunks(t):
        return t.reshape(B, N, GLA_CHUNK, H, t.shape[-1]).transpose(1, 0, 3, 2, 4)

    qc, kc, vc, gc = to_chunks(q), to_chunks(k), to_chunks(v), to_chunks(log_g)
    causal_in_chunk = jnp.tril(jnp.ones((GLA_CHUNK, GLA_CHUNK), dtype=bool))

    def step(S, xs):
        qi, ki, vi, gi = xs
        b = jnp.cumsum(gi, axis=2)
        b_last = b[:, :, -1:, :]
        q_dec = qi * jnp.exp(b)
        k_inv = ki * jnp.exp(-b)
        k_tail = ki * jnp.exp(b_last - b)
        a = jnp.where(causal_in_chunk, jnp.einsum('bhid,bhjd->bhij', q_dec, k_inv), 0.0)
        o = jnp.einsum('bhij,bhjv->bhiv', a, vi) + jnp.einsum('bhid,bhdv->bhiv', q_dec, S)
        S = S * jnp.exp(b_last)[:, :, 0, :, None] + jnp.einsum('bhjd,bhjv->bhdv', k_tail, vi)
        return S, o

    S0 = jnp.zeros((B, H, DK, DV), jnp.float32)
    _, o = lax.scan(step, S0, (qc, kc, vc, gc))
    return o.transpose(1, 0, 3, 2, 4).reshape(B, L, H, DV)


def gla_mixer(gq, gk, gv, gf, gb, og, w_gk_f, b_gk_f, w_gk_b, b_gk_b, gla_norm):
    B, L, _ = gq.shape
    f32 = jnp.float32
    qh = gq.astype(f32).reshape(B, L, GLA_HEADS, GLA_DK) * (GLA_DK ** -0.5)
    kh = gk.astype(f32).reshape(B, L, GLA_HEADS, GLA_DK)
    vh = gv.astype(f32).reshape(B, L, GLA_HEADS, GLA_DV)
    lg_f = (jax.nn.log_sigmoid((gf @ w_gk_f + b_gk_f).astype(f32)) / GLA_GATE_NORM).reshape(B, L, GLA_HEADS, GLA_DK)
    lg_b = (jax.nn.log_sigmoid((gb @ w_gk_b + b_gk_b).astype(f32)) / GLA_GATE_NORM).reshape(B, L, GLA_HEADS, GLA_DK)
    flip = lambda t: jnp.flip(t, axis=1)
    o = gla_scan(qh, kh, vh, lg_f) + flip(gla_scan(flip(qh), flip(kh), flip(vh), flip(lg_b)))
    o = rms_norm(o, gla_norm)
    o = o * jax.nn.silu(og.astype(f32)).reshape(B, L, GLA_HEADS, GLA_DV)
    return o.reshape(B, L, GLA_HEADS * GLA_DV).astype(gq.dtype)


def encoder_layer(x, w_in, q_a_norm, w_q_b, kv_a_norm, w_kv_b, w_gk_f, b_gk_f, w_gk_b, b_gk_b, gla_norm, w_out, pre_mix_norm, post_mix_norm, pre_mlp_norm, post_mlp_norm, w_up, w_down):
    split_points = np.cumsum(IN_SPLITS)[:-1].tolist()
    h = rms_norm(x, pre_mix_norm)
    c_q, c_kv, k_rope, gq, gk, gv, gf, gb, og = jnp.split(h @ w_in, split_points, axis=-1)
    mla_out = mla_attention(c_q, c_kv, k_rope, q_a_norm, w_q_b, kv_a_norm, w_kv_b)
    gla_out = gla_mixer(gq, gk, gv, gf, gb, og, w_gk_f, b_gk_f, w_gk_b, b_gk_b, gla_norm)
    mix = jnp.concatenate([mla_out, gla_out], axis=-1) @ w_out
    x = x + rms_norm(mix, post_mix_norm)
    h = rms_norm(x, pre_mlp_norm)
    f = jnp.square(jax.nn.relu(h @ w_up)) @ w_down
    return x + rms_norm(f, post_mlp_norm)


def trunk(x, w_in, q_a_norm, w_q_b, kv_a_norm, w_kv_b, w_gk_f, b_gk_f, w_gk_b, b_gk_b, gla_norm, w_out, pre_mix_norm, post_mix_norm, pre_mlp_norm, post_mlp_norm, w_up, w_down):
    for l in range(DEPTH):
        x = encoder_layer(x, w_in[l], q_a_norm[l], w_q_b[l], kv_a_norm[l], w_kv_b[l], w_gk_f[l], b_gk_f[l], w_gk_b[l], b_gk_b[l], gla_norm[l], w_out[l], pre_mix_norm[l], post_mix_norm[l], pre_mlp_norm[l], post_mlp_norm[l], w_up[l], w_down[l])
    return x


def setup_inputs(seed: int = 0) -> dict:
    key = jax.random.key(seed)
    ks = jax.random.split(key, 19)
    f32 = jnp.float32
    nrm = lambda k, shape, fan_in: jax.random.normal(k, shape, f32) * (fan_in ** -0.5)
    gain = lambda k, n: 1.0 + 0.02 * jax.random.normal(k, (DEPTH, n), f32)
    return {
        'x_prompt': jax.random.normal(ks[0], (BATCH, SEQ, D_MODEL), f32),
        'x_sample': jax.random.normal(ks[1], (DEC_BATCH, DEC_SEQ, D_MODEL), f32),
        'w_in': nrm(ks[2], (DEPTH, D_MODEL, IN_WIDTH), D_MODEL),
        'q_a_norm': gain(ks[3], Q_LORA),
        'w_q_b': nrm(ks[4], (DEPTH, Q_LORA, MLA_HEADS * (QK_NOPE + QK_ROPE)), Q_LORA),
        'kv_a_norm': gain(ks[5], KV_LORA),
        'w_kv_b': nrm(ks[6], (DEPTH, KV_LORA, MLA_HEADS * (QK_NOPE + V_HEAD)), KV_LORA),
        'w_gk_f': nrm(ks[7], (DEPTH, GLA_GATE_RANK, GLA_HEADS * GLA_DK), GLA_GATE_RANK),
        'b_gk_f': 0.1 * jax.random.normal(ks[8], (DEPTH, GLA_HEADS * GLA_DK), f32),
        'w_gk_b': nrm(ks[9], (DEPTH, GLA_GATE_RANK, GLA_HEADS * GLA_DK), GLA_GATE_RANK),
        'b_gk_b': 0.1 * jax.random.normal(ks[10], (DEPTH, GLA_HEADS * GLA_DK), f32),
        'gla_norm': gain(ks[11], GLA_DV),
        'w_out': nrm(ks[12], (DEPTH, MIX_WIDTH, D_MODEL), MIX_WIDTH),
        'pre_mix_norm': gain(ks[13], D_MODEL),
        'post_mix_norm': gain(ks[14], D_MODEL),
        'pre_mlp_norm': gain(ks[15], D_MODEL),
        'post_mlp_norm': gain(ks[16], D_MODEL),
        'w_up': nrm(ks[17], (DEPTH, D_MODEL, D_FF), D_MODEL),
        'w_down': nrm(ks[18], (DEPTH, D_FF, D_MODEL), D_FF),
    }


def reference(x_prompt, x_sample, w_in, q_a_norm, w_q_b, kv_a_norm, w_kv_b, w_gk_f, b_gk_f, w_gk_b, b_gk_b, gla_norm, w_out, pre_mix_norm, post_mix_norm, pre_mlp_norm, post_mlp_norm, w_up, w_down):
    y_prompt = trunk(x_prompt, w_in, q_a_norm, w_q_b, kv_a_norm, w_kv_b, w_gk_f, b_gk_f, w_gk_b, b_gk_b, gla_norm, w_out, pre_mix_norm, post_mix_norm, pre_mlp_norm, post_mlp_norm, w_up, w_down)
    y_sample = trunk(x_sample, w_in, q_a_norm, w_q_b, kv_a_norm, w_kv_b, w_gk_f, b_gk_f, w_gk_b, b_gk_b, gla_norm, w_out, pre_mix_norm, post_mix_norm, pre_mlp_norm, post_mlp_norm, w_up, w_down)
    return (y_prompt, y_sample)
```

```cpp
#include <hip/hip_runtime.h>
#include <hip/hip_cooperative_groups.h>
#include <cstdio>
namespace cg = cooperative_groups;

#define DI __device__ __forceinline__
#define LAS __attribute__((address_space(3)))
typedef unsigned short bf16_t;
typedef short bf16x8 __attribute__((ext_vector_type(8)));
typedef short s16x4 __attribute__((ext_vector_type(4)));
typedef float f32x2 __attribute__((ext_vector_type(2)));
typedef float f32x4 __attribute__((ext_vector_type(4)));
typedef float f32x16 __attribute__((ext_vector_type(16)));
typedef unsigned u32x2 __attribute__((ext_vector_type(2)));
typedef unsigned u32x4 __attribute__((ext_vector_type(4)));
typedef __bf16 bfv2 __attribute__((ext_vector_type(2)));

constexpr int T = 32768, TP = 16384, DM = 2048, DFF = 8192;
constexpr float EPS = 1e-6f;
constexpr int NIN_PAD = 4352;
constexpr float QSCALE = 0.07216878364870323f * 1.4426950408889634f;
constexpr float GLA_QS = 0.08838834764831845f;

constexpr size_t MiB = 1u << 20;
constexpr size_t OFF_WIN = 0, OFF_WQB = 17 * MiB, OFF_WKVB = OFF_WQB + 3 * MiB / 2, OFF_WOUT = OFF_WKVB + 2 * MiB,
                 OFF_WUP = OFF_WOUT + 8 * MiB, OFF_WDOWN = OFF_WUP + 32 * MiB;
constexpr size_t OFF_RS0 = 93 * MiB, OFF_RS2 = OFF_RS0 + 128 * 1024, OFF_CTR = OFF_RS2 + 128 * 1024,
                 OFF_SSQA = 94 * MiB, OFF_SSQM = 96 * MiB, OFF_ROPE = 100 * MiB;
constexpr size_t OFF_PROJG = 104 * MiB;
constexpr size_t OFF_PROJS = 296 * MiB;
constexpr size_t OFF_PROJA = 312 * MiB;
constexpr size_t OFF_XB = 376 * MiB;
constexpr size_t OFF_KPE = 504 * MiB;
constexpr size_t OFF_MIX = 104 * MiB;
constexpr size_t OFF_U = 104 * MiB;
constexpr size_t WS_NEED = 512 * MiB;
constexpr size_t DO_Q = 0, DO_OF = 96 * MiB, DO_OB = 160 * MiB, DO_P1 = 224 * MiB, DO_LSE = 240 * MiB;

constexpr int LDS_BYTES = 157696 + 512;
constexpr int N_IDLE_LATE = 4 * 656;
constexpr int N_SSPLIT = 4, N_ATTQ = 64 + N_SSPLIT + 64;

struct Params {
  const float *x0, *x1, *w_in, *q_a_norm, *w_q_b, *kv_a_norm, *w_kv_b, *w_gk_f, *b_gk_f, *w_gk_b, *b_gk_b, *gla_norm, *w_out,
      *pre_mix, *post_mix, *pre_mlp, *post_mlp, *w_up, *w_down;
  char* out; char* ws;
};

__device__ const double ROPE_INV[32] = {
1.0, 0.7498942093324559, 0.5623413251903491, 0.4216965034285823,
0.31622776601683794, 0.23713737056616555, 0.1778279410038923, 0.1333521432163324,
0.1, 0.07498942093324558, 0.056234132519034905, 0.042169650342858224,
0.03162277660168379, 0.02371373705661655, 0.01778279410038923, 0.01333521432163324,
0.01, 0.007498942093324559, 0.005623413251903491, 0.004216965034285823,
0.00316227766016838, 0.0023713737056616554, 0.001778279410038923, 0.001333521432163324,
0.001, 0.0007498942093324559, 0.0005623413251903491, 0.0004216965034285823,
0.00031622776601683794, 0.00023713737056616554, 0.0001778279410038923, 0.0001333521432163324};

DI unsigned pk2(float a, float b) { f32x2 v = {a, b}; bfv2 r = __builtin_convertvector(v, bfv2); return __builtin_bit_cast(unsigned, r); }
DI float bflo(unsigned w) { return __uint_as_float(w << 16); }
DI float bfhi(unsigned w) { return __uint_as_float(w & 0xffff0000u); }
DI float bf2f(short h) { return __uint_as_float(((unsigned)(unsigned short)h) << 16); }
DI float wave_sum(float v) {
#pragma unroll
  for (int o = 32; o > 0; o >>= 1) v += __shfl_xor(v, o);
  return v;
}
DI int crow(int r, int hi) { return (r & 3) + 8 * (r >> 2) + 4 * hi; }
DI bf16x8 pack8(const f32x16& x, int s) {
  u32x4 w = {pk2(x[8 * s + 0], x[8 * s + 1]), pk2(x[8 * s + 2], x[8 * s + 3]), pk2(x[8 * s + 4], x[8 * s + 5]), pk2(x[8 * s + 6], x[8 * s + 7])};
  return __builtin_bit_cast(bf16x8, w);
}
#define MFMA32(a, b, c) __builtin_amdgcn_mfma_f32_32x32x16_bf16((a), (b), (c), 0, 0, 0)

DI int colmap_in(int n) {
  if (n < 1024) return n;
  if (n < 3072) return n + 64;
  if (n < 4096) return n + 96;
  if (n < 4160) { const int m = n - 4096; return 1024 + (m >> 1) + 32 * (m & 1); }
  if (n < 4192) return 3136 + (n - 4160);
  return -1;
}
DI int colmap_qb(int n) {
  if (n < 1024) return (n >> 7) * 192 + (n & 127);
  const int m = n - 1024, h = m >> 6, r = m & 63;
  return h * 192 + 128 + (r >> 1) + 32 * (r & 1);
}
template <int CM>
DI void convT_tile(const float* __restrict__ src, int ldsrc, const float* __restrict__ gain, bf16_t* __restrict__ dst, int K, int k0, int n0, float* tile) {
  const int tid = threadIdx.x;
  {
    const int nn = tid & 63, kk0 = tid >> 6;
    const int n = n0 + nn;
    const int sc = CM == 1 ? colmap_in(n) : (CM == 2 ? colmap_qb(n) : n);
#pragma unroll
    for (int r = 0; r < 8; ++r) {
      const int kk = kk0 + 8 * r;
      float v = 0.f;
      if (sc >= 0) { v = src[(size_t)(k0 + kk) * ldsrc + sc]; if (gain) v *= gain[k0 + kk]; }
      tile[kk * 65 + nn] = v;
    }
  }
  __syncthreads();
  {
    const int kk8 = (tid & 7) * 8, n2 = tid >> 3;
    float v[8];
#pragma unroll
    for (int j = 0; j < 8; ++j) v[j] = tile[(kk8 + j) * 65 + n2];
    u32x4 w = {pk2(v[0], v[1]), pk2(v[2], v[3]), pk2(v[4], v[5]), pk2(v[6], v[7])};
    *(u32x4*)(dst + (size_t)(n0 + n2) * K + k0 + kk8) = w;
  }
  __syncthreads();
}

template <int CM>
DI void convT_tile4(const float* __restrict__ src, int ldsrc, const float* __restrict__ gain, bf16_t* __restrict__ dst, int K, int k0, int n0, float* tile) {
  const int tid = threadIdx.x;
  const int nn = tid & 63, kk0 = tid >> 6;
  const int sc = CM == 1 ? colmap_in(n0 + nn) : (CM == 2 ? colmap_qb(n0 + nn) : n0 + nn);
  float v[4][8];
#pragma unroll
  for (int t = 0; t < 4; ++t)
#pragma unroll
    for (int r = 0; r < 8; ++r) v[t][r] = sc >= 0 ? __builtin_nontemporal_load(src + (size_t)(k0 + 64 * t + kk0 + 8 * r) * ldsrc + sc) : 0.f;
  if (gain) {
#pragma unroll
    for (int t = 0; t < 4; ++t)
#pragma unroll
      for (int r = 0; r < 8; ++r) v[t][r] *= gain[k0 + 64 * t + kk0 + 8 * r];
  }
  const int kk8 = (tid & 7) * 8, n2 = tid >> 3;
#pragma unroll
  for (int t = 0; t < 4; ++t) {
#pragma unroll
    for (int r = 0; r < 8; ++r) tile[(kk0 + 8 * r) * 65 + nn] = v[t][r];
    __syncthreads();
    float w[8];
#pragma unroll
    for (int j = 0; j < 8; ++j) w[j] = tile[(kk8 + j) * 65 + n2];
    u32x4 o = {pk2(w[0], w[1]), pk2(w[2], w[3]), pk2(w[4], w[5]), pk2(w[6], w[7])};
    *(u32x4*)(dst + (size_t)(n0 + n2) * K + k0 + 64 * t + kk8) = o;
    __syncthreads();
  }
}

DI void phase0(const Params& p, char* lds) {
  const int tid = threadIdx.x, lane = tid & 63;
  char* ws = p.ws;
  if (blockIdx.x == 0) { for (int i = tid; i < 544; i += 512) ((unsigned*)(ws + OFF_CTR))[i] = i == 512 ? (unsigned)N_IDLE_LATE : 0u; for (int i = tid; i < 3200; i += 512) ((unsigned*)(ws + OFF_CTR))[1024 + i] = 0u; }
  {
    f32x2* tab = (f32x2*)(ws + OFF_ROPE);
    for (int idx = blockIdx.x * 512 + tid; idx < 16384 * 32; idx += gridDim.x * 512) {
      const int pos = idx >> 5, i = idx & 31;
      const double ang = (double)pos * ROPE_INV[i];
      const double kq = __builtin_rint(ang * 0.6366197723675814);
      double r = ang - kq * 1.5707963267948966;
      r = r - kq * 6.123233995736766e-17;
      const double r2 = r * r;
      double sn = r * (1.0 + r2 * (-1.0 / 6 + r2 * (1.0 / 120 + r2 * (-1.0 / 5040 + r2 * (1.0 / 362880 + r2 * (-1.0 / 39916800 + r2 * (1.0 / 6227020800.0)))))));
      double cs = 1.0 + r2 * (-0.5 + r2 * (1.0 / 24 + r2 * (-1.0 / 720 + r2 * (1.0 / 40320 + r2 * (-1.0 / 3628800 + r2 * (1.0 / 479001600.0 + r2 * (-1.0 / 87178291200.0)))))));
      const int q = ((int)kq) & 3;
      double c, s;
      if (q == 0) { c = cs; s = sn; } else if (q == 1) { c = -sn; s = cs; } else if (q == 2) { c = -cs; s = -sn; } else { c = sn; s = -cs; }
      tab[idx] = (f32x2){(float)c, (float)s};
    }
  }
  {
    bf16_t* XB = (bf16_t*)(ws + OFF_XB);
    float* rs0 = (float*)(ws + OFF_RS0);
    const int gw = blockIdx.x * 8 + (tid >> 6), nw = gridDim.x * 8;
    for (int row0 = gw; row0 < T; row0 += 2 * nw) {
      const int row1 = row0 + nw;
      const float* src0 = row0 < TP ? p.x0 + (size_t)row0 * DM : p.x1 + (size_t)(row0 - TP) * DM;
      const float* src1 = row1 < TP ? p.x0 + (size_t)row1 * DM : p.x1 + (size_t)(row1 - TP) * DM;
      f32x4 va[8], vb[8];
#pragma unroll
      for (int i = 0; i < 8; ++i) { va[i] = __builtin_nontemporal_load((const f32x4*)(src0 + (i * 64 + lane) * 4)); vb[i] = __builtin_nontemporal_load((const f32x4*)(src1 + (i * 64 + lane) * 4)); }
      float sa = 0.f, sb = 0.f;
#pragma unroll
      for (int i = 0; i < 8; ++i) {
        sa += va[i][0] * va[i][0] + va[i][1] * va[i][1] + va[i][2] * va[i][2] + va[i][3] * va[i][3];
        sb += vb[i][0] * vb[i][0] + vb[i][1] * vb[i][1] + vb[i][2] * vb[i][2] + vb[i][3] * vb[i][3];
        u32x2 w0 = {pk2(va[i][0], va[i][1]), pk2(va[i][2], va[i][3])}, w1 = {pk2(vb[i][0], vb[i][1]), pk2(vb[i][2], vb[i][3])};
        *(u32x2*)(XB + (size_t)row0 * DM + (i * 64 + lane) * 4) = w0;
        *(u32x2*)(XB + (size_t)row1 * DM + (i * 64 + lane) * 4) = w1;
      }
      sa = wave_sum(sa); sb = wave_sum(sb);
      if (lane == 0) { rs0[row0] = __builtin_amdgcn_rsqf(sa * (1.0f / DM) + EPS); rs0[row1] = __builtin_amdgcn_rsqf(sb * (1.0f / DM) + EPS); }
    }
  }
  {
    float* tile = (float*)lds;
    constexpr int NT = 32 * 68 / 4;
    for (int t = blockIdx.x; t < NT; t += gridDim.x) { const int u = 4 * t;
      convT_tile4<1>(p.w_in, 4192, p.pre_mix, (bf16_t*)(ws + OFF_WIN), 2048, (u & 31) * 64, (u >> 5) * 64, tile); }
  }
}
constexpr int NL3 = 32 * 32, NL4 = 32 * 128, NL5 = 128 * 32, N_LATE = NL3 + NL4 + NL5;
DI void conv_late_tile4(const Params& p, int t, char* lds) {
  float* tile = (float*)lds; char* ws = p.ws;
  int u = t;
  if (u < NL3) { convT_tile4<0>(p.w_out, 2048, nullptr, (bf16_t*)(ws + OFF_WOUT), 2048, (u & 31) * 64, (u >> 5) * 64, tile); return; }
  u -= NL3;
  if (u < NL4) { convT_tile4<0>(p.w_up, 8192, p.pre_mlp, (bf16_t*)(ws + OFF_WUP), 2048, (u & 31) * 64, (u >> 5) * 64, tile); return; }
  u -= NL4;
  convT_tile4<0>(p.w_down, 2048, nullptr, (bf16_t*)(ws + OFF_WDOWN), 8192, (u & 127) * 64, (u >> 7) * 64, tile);
}

DI void conv_idle_round(const Params& p, char* lds) {
  if (blockIdx.x < 128) return;
  float* tile = (float*)lds; char* ws = p.ws;
  __syncthreads();
  for (int g = (int)blockIdx.x - 128; g < 768; g += (int)gridDim.x - 128) {
    if (g < 48) { const int u = 4 * g; convT_tile4<2>(p.w_q_b, 1536, p.q_a_norm, (bf16_t*)(ws + OFF_WQB), 512, (u & 7) * 64, (u >> 3) * 64, tile); }
    else if (g < 112) { const int u = 4 * (g - 48); convT_tile4<0>(p.w_kv_b, 2048, p.kv_a_norm, (bf16_t*)(ws + OFF_WKVB), 512, (u & 7) * 64, (u >> 3) * 64, tile); }
    else conv_late_tile4(p, 4 * (g - 112), lds);
  }
}

namespace pg8 {
constexpr int BM = 256, BK = 64, HALF = 128, HTB = HALF * BK * 2, STAGE_BYTES = 8 * HTB, NXCD = 8, WGM = 8;
DI int lds_byte(int r, int c) { const int st = (r >> 4) * 2 + (c >> 5), rr = r & 15, cc = c & 31, ob = rr * 64 + cc * 2; return st * 1024 + (ob ^ (((ob >> 9) & 1) << 5)); }
DI void stage_rc(int b, int& R, int& C) { const int st = b / 1024, sb = b % 1024, swz = sb ^ (((sb >> 9) & 1) << 5); R = (st >> 1) * 16 + swz / 64; C = (st & 1) * 32 + (swz % 64) / 2; }
DI int perm32(int rho) { const int n = rho >> 4, i = rho & 15; return 8 * (i >> 2) + 4 * n + (i & 3); }
struct Unit { int pm, pn; };
struct Gemm { const bf16_t* A; const bf16_t* Bt; int M, N, K, lda; long segd; int tsplit; };
struct StaticOrder {
  int nM, nN, nwg, G, c, wgm;
  DI void init(int M, int N, int G_, int c_, int wgm_ = WGM) { nM = M / BM; nN = N / BM; nwg = nM * nN; G = G_; c = c_; wgm = wgm_; }
  DI bool next(int i, Unit& u) const {
    const long L = (long)i * G + c; if (L >= nwg) return false;
    int wgid = (int)L; { const int q = nwg / NXCD, r = nwg % NXCD, xcd = wgid % NXCD, off = wgid / NXCD; wgid = (xcd < r ? xcd * (q + 1) : r * (q + 1) + (xcd - r) * q) + off; }
    const int nig = wgm * nN, gid = wgid / nig, fm = gid * wgm, gsz = (nM - fm) < wgm ? (nM - fm) : wgm;
    u.pm = fm + ((wgid % nig) % gsz); u.pn = (wgid % nig) / gsz; return true;
  }
};

template <class Epi>
DI void gemm_phase(LAS unsigned char* lds, const Gemm g, const StaticOrder& S, const Epi& E) {
  const int tid = threadIdx.x, wid = __builtin_amdgcn_readfirstlane(tid >> 6), lane = tid & 63, wr = wid >> 2, wc = wid & 3, fr = lane & 15, fq = lane >> 4;
  const int K = g.K, nt = K / BK, lda = g.lda;
  unsigned voffA[2], voffB[2];
#pragma unroll
  for (int i = 0; i < 2; ++i) { int R, C; stage_rc(tid * 16 + i * 8192, R, C); const int Rb = (R & ~31) + perm32(R & 31);
    voffA[i] = (unsigned)(R * lda + C) * 2u; voffB[i] = (unsigned)(Rb * K + C) * 2u; }
  const size_t kstep = (size_t)(BK * 2);
  const size_t hstepA = (size_t)HALF * lda * 2, hstepB = (size_t)HALF * K * 2;
  const size_t tstepA = 2 * hstepA, tstepB = 2 * hstepB;
  const unsigned ldsw = (unsigned)wid * 1024u;
  const int aoff = lds_byte(wr * 64 + fr, fq * 8), boff = lds_byte(wc * 32 + fr, fq * 8);
  const int tsplit = g.tsplit; const long segd = g.segd;
#define PG8_AK(t) ((size_t)(t) * kstep + ((t) >= tsplit ? segd : 0))
#define PG8_SA(b, h) (((b) * 2 + (h)) * HTB)
#define PG8_SB(b, h) ((4 + (b) * 2 + (h)) * HTB)
#define PG8_STAGE(bufoff, gbase, voff) do { _Pragma("unroll") for (int _i = 0; _i < 2; ++_i) \
    __builtin_amdgcn_global_load_lds((const unsigned*)((const char*)(gbase) + (voff)[_i]), (LAS unsigned*)(lds + (bufoff) + ldsw + _i * 8192), 16, 0, 0); } while (0)
#define PG8_LDA(dst, b, h) do { _Pragma("unroll") for (int m = 0; m < 4; ++m) _Pragma("unroll") for (int k = 0; k < 2; ++k) dst[m][k] = *(const LAS bf16x8*)(lds + PG8_SA(b, h) + aoff + m * 2048 + k * 1024); } while (0)
#define PG8_LDB(dst, b, h) do { _Pragma("unroll") for (int n = 0; n < 2; ++n) _Pragma("unroll") for (int k = 0; k < 2; ++k) dst[n][k] = *(const LAS bf16x8*)(lds + PG8_SB(b, h) + boff + n * 2048 + k * 1024); } while (0)
#define PG8_MMA(ai, bj, At, Bt) do { __builtin_amdgcn_s_setprio(1); _Pragma("unroll") for (int m = 0; m < 4; ++m) _Pragma("unroll") for (int n = 0; n < 2; ++n) _Pragma("unroll") for (int k = 0; k < 2; ++k) \
    acc[ai][bj][m][n] = __builtin_amdgcn_mfma_f32_16x16x32_bf16(Bt[n][k], At[m][k], acc[ai][bj][m][n], 0, 0, 0); __builtin_amdgcn_s_setprio(0); } while (0)
#define PG8_WAIT_V(n) asm volatile("s_waitcnt vmcnt(" #n ")" ::: "memory")
#define PG8_WAIT_L(n) asm volatile("s_waitcnt lgkmcnt(" #n ")" ::: "memory")
#define PG8_BAR __builtin_amdgcn_s_barrier()
#define PG8_SCHED __builtin_amdgcn_sched_barrier(0)
  Unit cur, nxt; int ui = 0;
  if (!S.next(0, cur)) return;
  f32x4 acc[2][2][4][2];
#pragma unroll
  for (int a = 0; a < 2; ++a)
#pragma unroll
    for (int b = 0; b < 2; ++b)
#pragma unroll
      for (int m = 0; m < 4; ++m)
#pragma unroll
        for (int n = 0; n < 2; ++n) acc[a][b][m][n] = (f32x4){0.f, 0.f, 0.f, 0.f};
  bf16x8 At[4][2], B0[2][2], B1[2][2];
  const char* cA = (const char*)g.A + (size_t)cur.pm * tstepA; const char* cB = (const char*)g.Bt + (size_t)cur.pn * tstepB;
  PG8_STAGE(PG8_SB(0, 0), cB, voffB); PG8_STAGE(PG8_SA(0, 0), cA, voffA); PG8_STAGE(PG8_SB(0, 1), cB + hstepB, voffB); PG8_STAGE(PG8_SA(0, 1), cA + hstepA, voffA);
  if (wr == 1) PG8_BAR;
  PG8_WAIT_V(4); PG8_BAR;
  PG8_STAGE(PG8_SB(1, 0), cB + kstep, voffB); PG8_STAGE(PG8_SA(1, 0), cA + kstep, voffA); PG8_STAGE(PG8_SB(1, 1), cB + hstepB + kstep, voffB);
  PG8_WAIT_V(6); PG8_BAR;
  for (;;) {
    const bool has_next = S.next(ui + 1, nxt);
    const char* nA = has_next ? (const char*)g.A + (size_t)nxt.pm * tstepA : cA; const char* nB = has_next ? (const char*)g.Bt + (size_t)nxt.pn * tstepB : cB;
    for (int t = 0; t < nt; t += 2) {
      const bool last = (t == nt - 2);
      const char* a1 = cA + PG8_AK(t + 1);
      const char* a2 = last ? nA : cA + PG8_AK(t + 2); const char* b2 = last ? nB : cB + (size_t)(t + 2) * kstep;
      const char* a3 = a2 + kstep; const char* b3 = b2 + kstep;
      PG8_LDB(B0, 0, 0); PG8_SCHED; PG8_LDA(At, 0, 0); PG8_STAGE(PG8_SA(1, 1), a1 + hstepA, voffA);
      PG8_WAIT_L(8); PG8_BAR; PG8_WAIT_L(0); PG8_MMA(0, 0, At, B0); PG8_BAR; PG8_SCHED;
      PG8_LDB(B1, 0, 1); PG8_STAGE(PG8_SB(0, 0), b2, voffB);
      PG8_BAR; PG8_WAIT_L(0); PG8_MMA(0, 1, At, B1); PG8_BAR;
      PG8_LDA(At, 0, 1); PG8_STAGE(PG8_SA(0, 0), a2, voffA);
      PG8_BAR; PG8_WAIT_L(0); PG8_MMA(1, 0, At, B0); PG8_BAR; PG8_SCHED;
      PG8_STAGE(PG8_SB(0, 1), b2 + hstepB, voffB);
      PG8_WAIT_V(6); PG8_BAR; PG8_MMA(1, 1, At, B1); PG8_BAR;
      PG8_LDB(B0, 1, 0); PG8_SCHED; PG8_LDA(At, 1, 0); PG8_STAGE(PG8_SA(0, 1), a2 + hstepA, voffA);
      PG8_WAIT_L(8); PG8_BAR; PG8_WAIT_L(0); PG8_MMA(0, 0, At, B0); PG8_BAR; PG8_SCHED;
      PG8_LDB(B1, 1, 1); PG8_STAGE(PG8_SB(1, 0), b3, voffB);
      PG8_BAR; PG8_WAIT_L(0); PG8_MMA(0, 1, At, B1); PG8_BAR;
      PG8_LDA(At, 1, 1); PG8_STAGE(PG8_SA(1, 0), a3, voffA);
      PG8_BAR; PG8_WAIT_L(0); PG8_MMA(1, 0, At, B0); PG8_BAR; PG8_SCHED;
      PG8_STAGE(PG8_SB(1, 1), b3 + hstepB, voffB);
      PG8_WAIT_V(6); PG8_BAR; PG8_MMA(1, 1, At, B1); PG8_BAR;
    }
    E(acc, cur, wr, wc, fr, fq);
    if (!has_next) break;
#pragma unroll
    for (int a = 0; a < 2; ++a)
#pragma unroll
      for (int b = 0; b < 2; ++b)
#pragma unroll
        for (int m = 0; m < 4; ++m)
#pragma unroll
          for (int n = 0; n < 2; ++n) acc[a][b][m][n] = (f32x4){0.f, 0.f, 0.f, 0.f};
    cur = nxt; cA = nA; cB = nB; ++ui;
  }
  PG8_WAIT_V(0);
  if (wr == 0) PG8_BAR;
  PG8_BAR;
#undef PG8_AK
#undef PG8_SA
#undef PG8_SB
#undef PG8_STAGE
#undef PG8_LDA
#undef PG8_LDB
#undef PG8_MMA
#undef PG8_WAIT_V
#undef PG8_WAIT_L
#undef PG8_BAR
#undef PG8_SCHED
}
}

enum { EP_IN = 0, EP_Q = 1, EP_KV = 2, EP_MIX = 3, EP_UP = 4, EP_DOWN = 5 };
template <int MODE> struct Epi {
  char* ws; char* dout; int rowbase;
  DI void operator()(const f32x4 (&acc)[2][2][4][2], const pg8::Unit& u, int wr, int wc, int fr, int fq) const {
    const int pn = u.pn;
    const int cl = wc * 32 + 8 * fq;
#pragma unroll
    for (int ai = 0; ai < 2; ++ai)
#pragma unroll
      for (int m = 0; m < 4; ++m) {
        const int row = u.pm * 256 + ai * 128 + wr * 64 + m * 16 + fr;
        const int grow = rowbase + row;
        float rs = 1.f;
        if (MODE == EP_IN) rs = ((const float*)(ws + OFF_RS0))[grow];
        if (MODE == EP_UP) rs = ((const float*)(ws + OFF_RS2))[grow];
        if (MODE == EP_Q || MODE == EP_KV) {
          const f32x4* sp = (const f32x4*)(ws + OFF_SSQA) + (size_t)grow * 4 + (MODE == EP_KV ? 2 : 0);
          const f32x4 s0 = sp[0], s1 = sp[1];
          const float ss = (s0[0] + s0[1]) + (s0[2] + s0[3]) + (s1[0] + s1[1]) + (s1[2] + s1[3]);
          rs = __builtin_amdgcn_rsqf(ss * (1.0f / 512) + EPS);
          if (MODE == EP_Q) rs *= QSCALE;
        }
        float ssq = 0.f;
#pragma unroll
        for (int bj = 0; bj < 2; ++bj) {
          f32x4 v0 = acc[ai][bj][m][0] * rs, v1 = acc[ai][bj][m][1] * rs;
          if (MODE == EP_IN || MODE == EP_MIX || MODE == EP_DOWN) {
#pragma unroll
            for (int j = 0; j < 4; ++j) ssq += v0[j] * v0[j] + v1[j] * v1[j];
          }
          if (MODE == EP_UP) {
#pragma unroll
            for (int j = 0; j < 4; ++j) { float a = fmaxf(v0[j], 0.f), b = fmaxf(v1[j], 0.f); v0[j] = a * a; v1[j] = b * b; }
          }
          bf16_t* dst;
          const int ct = bj * 128 + cl;
          if (MODE == EP_IN) {
            if (pn < 4) dst = (bf16_t*)(ws + OFF_PROJA) + (size_t)grow * 1024 + pn * 256 + ct;
            else if (pn < 16) dst = (bf16_t*)(ws + OFF_PROJG) + (size_t)grow * 3072 + (pn - 4) * 256 + ct;
            else if (ct < 64) {
              dst = (bf16_t*)(ws + OFF_KPE) + (size_t)grow * 64 + ct;
              const int pos = grow < TP ? (grow & 4095) : grow - TP;
              const f32x4* tb = (const f32x4*)((const f32x2*)(ws + OFF_ROPE) + pos * 32 + (ct >> 1));
              const f32x4 t0 = tb[0], t1 = tb[1];
              f32x4 o0, o1;
              o0[0] = v0[0] * t0[0] - v0[1] * t0[1]; o0[1] = v0[1] * t0[0] + v0[0] * t0[1];
              o0[2] = v0[2] * t0[2] - v0[3] * t0[3]; o0[3] = v0[3] * t0[2] + v0[2] * t0[3];
              o1[0] = v1[0] * t1[0] - v1[1] * t1[1]; o1[1] = v1[1] * t1[0] + v1[0] * t1[1];
              o1[2] = v1[2] * t1[2] - v1[3] * t1[3]; o1[3] = v1[3] * t1[2] + v1[2] * t1[3];
              v0 = o0; v1 = o1;
            }
            else dst = (bf16_t*)(ws + OFF_PROJS) + (size_t)grow * 256 + ct;
          } else if (MODE == EP_Q) {
            if (pn < 4) dst = (bf16_t*)(dout + DO_Q) + (size_t)grow * 1536 + (pn * 2 + bj) * 192 + cl;
            else {
              const int mm = (pn - 4) * 256 + ct, h = mm >> 6, r = mm & 63;
              dst = (bf16_t*)(dout + DO_Q) + (size_t)grow * 1536 + h * 192 + 128 + r;
              const int pos = grow < TP ? (grow & 4095) : grow - TP;
              const f32x4* tb = (const f32x4*)((const f32x2*)(ws + OFF_ROPE) + pos * 32 + (r >> 1));
              const f32x4 t0 = tb[0], t1 = tb[1];
              f32x4 o0, o1;
              o0[0] = v0[0] * t0[0] - v0[1] * t0[1]; o0[1] = v0[1] * t0[0] + v0[0] * t0[1];
              o0[2] = v0[2] * t0[2] - v0[3] * t0[3]; o0[3] = v0[3] * t0[2] + v0[2] * t0[3];
              o1[0] = v1[0] * t1[0] - v1[1] * t1[1]; o1[1] = v1[1] * t1[0] + v1[0] * t1[1];
              o1[2] = v1[2] * t1[2] - v1[3] * t1[3]; o1[3] = v1[3] * t1[2] + v1[2] * t1[3];
              v0 = o0; v1 = o1;
            }
          } else if (MODE == EP_KV) {
            dst = (bf16_t*)(ws + OFF_XB) + (size_t)grow * 2048 + pn * 256 + ct;
          } else if (MODE == EP_MIX) {
            dst = (bf16_t*)(ws + OFF_MIX) + (size_t)grow * 2048 + pn * 256 + ct;
          } else if (MODE == EP_UP) {
            dst = (bf16_t*)(ws + OFF_U) + (size_t)row * 8192 + pn * 256 + ct;
          } else {
            dst = (bf16_t*)dout + (size_t)grow * 4096 + pn * 256 + ct;
          }
          u32x4 w = {pk2(v0[0], v0[1]), pk2(v0[2], v0[3]), pk2(v1[0], v1[1]), pk2(v1[2], v1[3])};
          *(u32x4*)dst = w;
        }
        if (MODE == EP_IN || MODE == EP_MIX || MODE == EP_DOWN) {
          ssq += __shfl_xor(ssq, 16); ssq += __shfl_xor(ssq, 32);
          if (fq == 0) {
            if (MODE == EP_IN) { if (pn < 4) ((float*)(ws + OFF_SSQA))[(size_t)grow * 16 + pn * 4 + wc] = ssq; }
            else ((float*)(ws + OFF_SSQM))[(size_t)grow * 32 + pn * 4 + wc] = ssq;
          }
        }
      }
  }
};

template <int MODE>
DI void run_gemm(const Params& p, char* lds, const bf16_t* A, int lda, const bf16_t* Bt, int M, int N, int K, int rowbase, long segd = 0, int tsplit = 1 << 30) {
  pg8::Gemm g; g.A = A; g.Bt = Bt; g.M = M; g.N = N; g.K = K; g.lda = lda; g.segd = segd; g.tsplit = tsplit;
  pg8::StaticOrder S; S.init(M, N, gridDim.x, blockIdx.x, MODE == EP_UP ? 4 : pg8::WGM);
  Epi<MODE> E; E.ws = p.ws; E.dout = p.out; E.rowbase = rowbase;
  pg8::gemm_phase((LAS unsigned char*)lds, g, S, E);
}

constexpr int A_SHM_V = 64 * 128 * 2, A_SHM_K = 64 * 128 * 2, A_SHM_P = 64 * 64 * 2;
#define KSWZ(row, colB) ((row) * 256 + ((colB) ^ (((row) & 15) << 4)))
#define PSWZ(row, colB) ((row) * 128 + ((colB) ^ ((((row) >> 1) & 7) << 4)))
#define SBAR() __builtin_amdgcn_sched_barrier(0)
constexpr float ATH = 11.5f;
DI void a_partialSM(f32x16& p0, f32x16& p1, float& m_reg, float& mn, float& alpha) {
  float pmax = p0[0];
#pragma unroll
  for (int r = 1; r < 16; ++r) pmax = fmaxf(pmax, p0[r]);
#pragma unroll
  for (int r = 0; r < 16; ++r) pmax = fmaxf(pmax, p1[r]);
  { auto rr = __builtin_amdgcn_permlane32_swap(__float_as_uint(pmax), __float_as_uint(pmax), false, false);
    pmax = fmaxf(__uint_as_float(rr[0]), __uint_as_float(rr[1])); }
  if (__builtin_expect(__all(pmax - m_reg <= ATH), 1)) { mn = m_reg; alpha = 1.f; }
  else { mn = fmaxf(m_reg, pmax); alpha = __builtin_amdgcn_exp2f(m_reg - mn); m_reg = mn; }
#pragma unroll
  for (int r = 0; r < 16; ++r) p0[r] = p0[r] - mn;
#pragma unroll
  for (int r = 0; r < 16; ++r) p1[r] = p1[r] - mn;
#pragma unroll
  for (int r = 0; r < 16; ++r) p0[r] = __builtin_amdgcn_exp2f(p0[r]);
}
DI void a_finishSM(f32x16& p0, f32x16& p1, float alpha, float& l_reg, bf16x8& pa0, bf16x8& pa1, bf16x8& pa2, bf16x8& pa3) {
#pragma unroll
  for (int r = 0; r < 16; ++r) p1[r] = __builtin_amdgcn_exp2f(p1[r]);
  float ps = 0;
#pragma unroll
  for (int r = 0; r < 16; ++r) ps += p0[r];
#pragma unroll
  for (int r = 0; r < 16; ++r) ps += p1[r];
  { auto rr = __builtin_amdgcn_permlane32_swap(__float_as_uint(ps), __float_as_uint(ps), false, false);
    ps = __uint_as_float(rr[0]) + __uint_as_float(rr[1]); }
  l_reg = l_reg * alpha + ps;
#define PK4(P, BASE, OUT) do { unsigned a0 = pk2(P[BASE + 0], P[BASE + 1]), a1 = pk2(P[BASE + 2], P[BASE + 3]);   \
    unsigned b0 = pk2(P[BASE + 4], P[BASE + 5]), b1 = pk2(P[BASE + 6], P[BASE + 7]);                              \
    auto r0 = __builtin_amdgcn_permlane32_swap(a0, b0, false, false); auto r1 = __builtin_amdgcn_permlane32_swap(a1, b1, false, false); \
    u32x4 w = {r0[0], r1[0], r0[1], r1[1]}; OUT = __builtin_bit_cast(bf16x8, w); } while (0)
  PK4(p0, 0, pa0); PK4(p0, 8, pa1); PK4(p1, 0, pa2); PK4(p1, 8, pa3);
#undef PK4
}
DI void a_qkt(f32x16& p0, f32x16& p1, const char* Ks, const char* Ps, const bf16x8* qr, const char* QP, int r32, int hi) {
  p0 = f32x16{}; p1 = f32x16{};
#pragma unroll
  for (int d0 = 0; d0 < 8; ++d0) { const int cb = (d0 * 16 + hi * 8) * 2;
    bf16x8 b0 = *reinterpret_cast<const bf16x8*>(Ks + KSWZ(r32, cb));
    bf16x8 b1 = *reinterpret_cast<const bf16x8*>(Ks + KSWZ(32 + r32, cb));
    p0 = MFMA32(b0, qr[d0], p0);
    p1 = MFMA32(b1, qr[d0], p1); }
#pragma unroll
  for (int d0 = 0; d0 < 4; ++d0) { const int cb = (d0 * 16 + hi * 8) * 2;
    bf16x8 b0 = *reinterpret_cast<const bf16x8*>(Ps + PSWZ(r32, cb));
    bf16x8 b1 = *reinterpret_cast<const bf16x8*>(Ps + PSWZ(32 + r32, cb));
    const bf16x8 qp = *reinterpret_cast<const bf16x8*>(QP + d0 * 1024);
    p0 = MFMA32(b0, qp, p0);
    p1 = MFMA32(b1, qp, p1); }
}
DI int v_st(int k, int c) { const int kk = (k & ~0xC) | ((k & 4) << 1) | ((k & 8) >> 1); return ((kk >> 3) * 4 + (c >> 5)) * 512 + ((kk & 7) * 32 + (c & 31)) * 2; }
DI int v_rd_base(int lane) { return ((lane & 3) << 3) | (((lane >> 2) & 3) << 6) | (((lane >> 4) & 1) << 5) | (((lane >> 5) & 1) << 8); }
constexpr int v_rd_off(int d0, int ks, int half) { return d0 * 512 + ks * 4096 + half * 2048; }
template <int OFF> DI s16x4 tr_read(int vb) {
  s16x4 r; asm volatile("ds_read_b64_tr_b16 %0, %1 offset:%2" : "=&v"(r) : "v"(vb), "i"(OFF) : "memory"); return r;
}
template <int D0> DI void pv_one(f32x16& od, int vb, bf16x8 pa0, bf16x8 pa1, bf16x8 pa2, bf16x8 pa3) {
  const s16x4 l0 = tr_read<v_rd_off(D0, 0, 0)>(vb), h0 = tr_read<v_rd_off(D0, 0, 1)>(vb), l1 = tr_read<v_rd_off(D0, 1, 0)>(vb), h1 = tr_read<v_rd_off(D0, 1, 1)>(vb);
  const s16x4 l2 = tr_read<v_rd_off(D0, 2, 0)>(vb), h2 = tr_read<v_rd_off(D0, 2, 1)>(vb), l3 = tr_read<v_rd_off(D0, 3, 0)>(vb), h3 = tr_read<v_rd_off(D0, 3, 1)>(vb);
  asm volatile("s_waitcnt lgkmcnt(0)" ::: "memory"); SBAR();
#define PKV(L, H) (bf16x8){L[0], L[1], L[2], L[3], H[0], H[1], H[2], H[3]}
  od = MFMA32(pa0, PKV(l0, h0), od);
  od = MFMA32(pa1, PKV(l1, h1), od);
  od = MFMA32(pa2, PKV(l2, h2), od);
  od = MFMA32(pa3, PKV(l3, h3), od);
#undef PKV
}
DI void pv_d0(f32x16* o, int vb, bf16x8 pa0, bf16x8 pa1, bf16x8 pa2, bf16x8 pa3) {
  pv_one<0>(o[0], vb, pa0, pa1, pa2, pa3); pv_one<1>(o[1], vb, pa0, pa1, pa2, pa3); pv_one<2>(o[2], vb, pa0, pa1, pa2, pa3); pv_one<3>(o[3], vb, pa0, pa1, pa2, pa3);
}

#define PV_BLOCK(D0) { \
    const s16x4 l0 = tr_read<v_rd_off(D0, 0, 0)>(vb), h0 = tr_read<v_rd_off(D0, 0, 1)>(vb), l1 = tr_read<v_rd_off(D0, 1, 0)>(vb), h1 = tr_read<v_rd_off(D0, 1, 1)>(vb); \
    const s16x4 l2 = tr_read<v_rd_off(D0, 2, 0)>(vb), h2 = tr_read<v_rd_off(D0, 2, 1)>(vb), l3 = tr_read<v_rd_off(D0, 3, 0)>(vb), h3 = tr_read<v_rd_off(D0, 3, 1)>(vb); \
    asm volatile("s_waitcnt lgkmcnt(0)" ::: "memory"); SBAR(); \
    o[D0] = MFMA32(pa0, ((bf16x8){l0[0], l0[1], l0[2], l0[3], h0[0], h0[1], h0[2], h0[3]}), o[D0]); \
    o[D0] = MFMA32(pa1, ((bf16x8){l1[0], l1[1], l1[2], l1[3], h1[0], h1[1], h1[2], h1[3]}), o[D0]); \
    o[D0] = MFMA32(pa2, ((bf16x8){l2[0], l2[1], l2[2], l2[3], h2[0], h2[1], h2[2], h2[3]}), o[D0]); \
    o[D0] = MFMA32(pa3, ((bf16x8){l3[0], l3[1], l3[2], l3[3], h3[0], h3[1], h3[2], h3[3]}), o[D0]); }
DI void pv_sm(f32x16* o, int vb, bf16x8 pa0, bf16x8 pa1, bf16x8 pa2, bf16x8 pa3, f32x16& p0, f32x16& p1, float& m_reg, float& mn, float& alpha) {
  PV_BLOCK(0)
  float pm0 = p0[0];
#pragma unroll
  for (int r = 1; r < 16; ++r) pm0 = fmaxf(pm0, p0[r]);
  PV_BLOCK(1)
  float pmax = pm0;
#pragma unroll
  for (int r = 0; r < 16; ++r) pmax = fmaxf(pmax, p1[r]);
  { auto rr = __builtin_amdgcn_permlane32_swap(__float_as_uint(pmax), __float_as_uint(pmax), false, false);
    pmax = fmaxf(__uint_as_float(rr[0]), __uint_as_float(rr[1])); }
  const bool keep = __all(pmax - m_reg <= ATH);
  mn = keep ? m_reg : fmaxf(m_reg, pmax);
  alpha = __builtin_amdgcn_exp2f(m_reg - mn);
  m_reg = mn;
  PV_BLOCK(2)
#pragma unroll
  for (int r = 0; r < 16; ++r) { p0[r] = p0[r] - mn; p1[r] = p1[r] - mn; }
  PV_BLOCK(3)
#pragma unroll
  for (int r = 0; r < 16; ++r) p0[r] = __builtin_amdgcn_exp2f(p0[r]);
}

DI void attn_unit(const bf16_t* __restrict__ Qb, const bf16_t* __restrict__ Kh, const bf16_t* __restrict__ Vh, const bf16_t* __restrict__ Ph,
                  bf16_t* __restrict__ Ob, int seq, float* __restrict__ lse_out, char* lds) {
  constexpr int LDQ = 1536, LDK = 2048, LDP = 64, LDO = 1024;
  int tid = threadIdx.x; asm volatile("" : "+v"(tid));
  const int wid = tid >> 6, lane = tid & 63, r32 = lane & 31, hi = lane >> 5;
  constexpr int A_STG = 40960, A_KO = 16384, A_PO = 32768;
  float* wsf = (float*)(lds + 155648) + wid * 64; float* li_l = wsf; float* al_l = wsf + 32;
  float m_reg = -1e30f, l_reg = 0; f32x16 o[4] = {}; bf16x8 qr[8];
  char* QP = lds + 122880 + wid * 4096 + lane * 16;
  const bf16_t* Qw = Qb + (long)(wid * 32 + r32) * LDQ + hi * 8;
#pragma unroll
  for (int d0 = 0; d0 < 8; ++d0) qr[d0] = *reinterpret_cast<const bf16x8*>(Qw + d0 * 16);
#pragma unroll
  for (int d0 = 0; d0 < 4; ++d0) *reinterpret_cast<bf16x8*>(QP + d0 * 1024) = *reinterpret_cast<const bf16x8*>(Qw + 128 + d0 * 16);
  const int sr = tid >> 4, sc = (tid & 15) * 8, vst0 = v_st(sr, sc), vst1 = v_st(32 + sr, sc);
  const int pr = tid >> 3, pc = (tid & 7) * 8;
  const int vb0 = (int)(unsigned)(size_t)(LAS char*)lds + v_rd_base(lane);
  bf16x8 vs0, vs1, ks0, ks1, ps0;
#define SLOAD(k0) do { vs0 = *(const bf16x8*)(&Vh[(long)((k0) + sr) * LDK + sc]); vs1 = *(const bf16x8*)(&Vh[(long)((k0) + 32 + sr) * LDK + sc]); \
    ks0 = *(const bf16x8*)(&Kh[(long)((k0) + sr) * LDK + sc]); ks1 = *(const bf16x8*)(&Kh[(long)((k0) + 32 + sr) * LDK + sc]); \
    ps0 = *(const bf16x8*)(&Ph[(long)((k0) + pr) * LDP + pc]); } while (0)
#define SWRITE(st) do { char* b_ = lds + (st); *(bf16x8*)(b_ + vst0) = vs0; *(bf16x8*)(b_ + vst1) = vs1; const int kc = sc * 2; \
    *(bf16x8*)(b_ + A_KO + KSWZ(sr, kc)) = ks0; *(bf16x8*)(b_ + A_KO + KSWZ(32 + sr, kc)) = ks1; \
    *(bf16x8*)(b_ + A_PO + PSWZ(pr, pc * 2)) = ps0; } while (0)
#define SWAIT() asm volatile("s_waitcnt vmcnt(0)" ::: "memory")
#define RESC(a) do { if (__any((a) < 1.f)) { if (hi == 0) al_l[r32] = (a); asm volatile("s_waitcnt lgkmcnt(0)" ::: "memory"); \
    _Pragma("unroll") for (int d = 0; d < 4; ++d) _Pragma("unroll") for (int r = 0; r < 16; ++r) o[d][r] *= al_l[crow(r, hi)]; } } while (0)
  f32x16 pA0, pA1, pB0, pB1; float mnA, mnB, alA, alB; bf16x8 pa0, pa1, pa2, pa3; const int NT = seq / 64;
  SLOAD(0); SWAIT(); SWRITE(0); __syncthreads();
  a_qkt(pA0, pA1, lds + A_KO, lds + A_PO, qr, QP, r32, hi); a_partialSM(pA0, pA1, m_reg, mnA, alA);
  SLOAD(64);
  SWAIT(); SWRITE(A_STG); __syncthreads();
  int sV = 0, sK = A_STG, sW = 2 * A_STG;
  for (int j = 1; j + 1 < NT; j += 2) {
    SBAR(); a_qkt(pB0, pB1, lds + sK + A_KO, lds + sK + A_PO, qr, QP, r32, hi);
    a_finishSM(pA0, pA1, alA, l_reg, pa0, pa1, pa2, pa3); SBAR();
    SLOAD((j + 1) * 64); SBAR();
    pv_sm(o, vb0 + sV, pa0, pa1, pa2, pa3, pB0, pB1, m_reg, mnB, alB);
    SWAIT(); SWRITE(sW);
    RESC(alB); __syncthreads();
    { const int t_ = sV; sV = sK; sK = sW; sW = t_; }
    SBAR(); a_qkt(pA0, pA1, lds + sK + A_KO, lds + sK + A_PO, qr, QP, r32, hi);
    a_finishSM(pB0, pB1, alB, l_reg, pa0, pa1, pa2, pa3); SBAR();
    SLOAD((j + 2) * 64); SBAR();
    pv_sm(o, vb0 + sV, pa0, pa1, pa2, pa3, pA0, pA1, m_reg, mnA, alA);
    SWAIT(); SWRITE(sW);
    RESC(alA); __syncthreads();
    { const int t_ = sV; sV = sK; sK = sW; sW = t_; }
  }
  SBAR(); a_qkt(pB0, pB1, lds + sK + A_KO, lds + sK + A_PO, qr, QP, r32, hi);
  a_finishSM(pA0, pA1, alA, l_reg, pa0, pa1, pa2, pa3); SBAR();
  pv_sm(o, vb0 + sV, pa0, pa1, pa2, pa3, pB0, pB1, m_reg, mnB, alB);
  __syncthreads(); RESC(alB);
  a_finishSM(pB0, pB1, alB, l_reg, pa0, pa1, pa2, pa3); SBAR();
  pv_d0(o, vb0 + sK, pa0, pa1, pa2, pa3);
  if (hi == 0) li_l[r32] = l_reg; asm volatile("s_waitcnt lgkmcnt(0)" ::: "memory");
  if (lse_out != nullptr && hi == 0) lse_out[wid * 32 + r32] = m_reg + __builtin_amdgcn_logf(l_reg);
  float rli[16];
#pragma unroll
  for (int r = 0; r < 16; ++r) rli[r] = __builtin_amdgcn_rcpf(li_l[crow(r, hi)]);
  bf16_t* Ow = Ob + (long)(wid * 32) * LDO;
#pragma unroll
  for (int r = 0; r < 16; ++r) { const int orow = crow(r, hi);
#pragma unroll
    for (int d0 = 0; d0 < 4; ++d0) { const float v = o[d0][r] * rli[r]; Ow[(long)orow * LDO + d0 * 32 + r32] = (bf16_t)(pk2(v, v) & 0xffffu); } }
#undef SLOAD
#undef SWRITE
#undef SWAIT
#undef RESC
}

constexpr int G_QD = 0, G_KI = 17408, G_KT = 34816, G_VT = 53248, G_XS = 90112, G_GF = 99328, G_GT = 103424, G_DEC = 107520, G_WG = 108032, G_WGL = 114176, G_OT = 120320;
constexpr int QDS = 272, KTS = 144;
#define LBAR() do { asm volatile("s_waitcnt lgkmcnt(0)" ::: "memory"); __builtin_amdgcn_s_barrier(); asm volatile("" ::: "memory"); } while (0)
DI float logsig16(float z) { return -(fmaxf(-z, 0.f) + __logf(1.f + __expf(-fabsf(z)))) * (1.0f / 16.0f); }

DI void gla_task(const Params& p, int task, char* lds) {
  int tid = threadIdx.x; asm volatile("" : "+v"(tid));
  const int wid = __builtin_amdgcn_readfirstlane(tid >> 6), lane = tid & 63, r32_ = lane & 31, hi_ = lane >> 5;
  int seqstart, NC, sub, vh = 0; bool split = false;
  if (task < 16) { seqstart = TP; NC = 256; sub = task >> 1; vh = task & 1; split = true; } else { const int t2 = task - 16; seqstart = (t2 >> 3) * 4096; NC = 64; sub = t2 & 7; }
  const int dir = sub & 1, h = sub >> 1;
  const int dvb = split ? 4 * vh + wid : wid;
  const bool act = !split || wid < 4;
  const bf16_t* PG = (const bf16_t*)(p.ws + OFF_PROJG);
  const bf16_t* PS = (const bf16_t*)(p.ws + OFF_PROJS);
  bf16_t* OUT = (bf16_t*)(p.out + (dir ? DO_OB : DO_OF));
  const int chp = tid & 63, g = wid, c0_ = 2 * chp;
  __syncthreads();
  {
    const float* W = dir ? p.w_gk_b : p.w_gk_f;
    for (int i = tid; i < 16 * 128; i += 512) {
      const int kk = i >> 7, ch = i & 127;
      const float w = W[kk * 512 + h * 128 + ch];
      const unsigned hb = pk2(w, w) & 0xffffu;
      const float wl = w - __uint_as_float(hb << 16);
      *(short*)(lds + G_WG + ch * 48 + kk * 2) = (short)hb;
      *(short*)(lds + G_WGL + ch * 48 + kk * 2) = (short)(pk2(wl, wl) & 0xffffu);
    }
    if (tid < 64) {
      const int l15 = tid & 15, q4 = tid >> 4;
      *(u32x2*)(lds + G_XS + l15 * KTS + (16 + 4 * q4) * 2) = (u32x2){0u, 0u};
      *(u32x2*)(lds + G_XS + (32 + l15) * KTS + (48 + 4 * q4) * 2) = (u32x2){0u, 0u};
    }
  }
  const float biasm = ((dir ? p.b_gk_b : p.b_gk_f) + h * 128)[32 * (wid & 3) + r32_];
  f32x16 S[4] = {};
  const int spos_ = tid >> 3, sc8_ = (tid & 7) * 8;
  const int vsr_ = tid >> 4, vsc_ = (tid & 15) * 8;
  bf16x8 rq0, rq1, rk0, rk1, rv0, rv1, rv2, rv3, rg;
  rg = bf16x8{}; rv0 = bf16x8{}; rv1 = bf16x8{}; rv2 = bf16x8{}; rv3 = bf16x8{};
#define GLOAD(n) do { const int c_ = dir ? NC - 1 - (n) : (n); const long tok_ = (long)seqstart + c_ * 64 + (dir ? 63 - spos : spos); \
    const bf16_t* rp_ = PG + tok_ * 3072; \
    rq0 = *(const bf16x8*)(rp_ + h * 128 + sc8); rq1 = *(const bf16x8*)(rp_ + h * 128 + 64 + sc8); \
    rk0 = *(const bf16x8*)(rp_ + 512 + h * 128 + sc8); rk1 = *(const bf16x8*)(rp_ + 512 + h * 128 + 64 + sc8); \
    { const long tv0_ = (long)seqstart + c_ * 64 + (dir ? 63 - vsr : vsr), tv1_ = (long)seqstart + c_ * 64 + (dir ? 31 - vsr : 32 + vsr); \
      const bf16_t* v0_ = PG + tv0_ * 3072 + 1024 + h * 256 + vsc; const bf16_t* v1_ = PG + tv1_ * 3072 + 1024 + h * 256 + vsc; \
      if (!split || vh == 0) { rv0 = *(const bf16x8*)(v0_); rv1 = *(const bf16x8*)(v1_); } if (!split || vh == 1) { rv2 = *(const bf16x8*)(v0_ + 128); rv3 = *(const bf16x8*)(v1_ + 128); } } \
    if (tid < 128) { const long tg_ = (long)seqstart + c_ * 64 + (dir ? 63 - (tid >> 1) : (tid >> 1)); rg = *(const bf16x8*)(PS + tg_ * 256 + 64 + dir * 16 + (tid & 1) * 8); } } while (0)
#define GFL_READ() do { const int ch_ = lane_v & 3, p0_ = lane_v >> 2; \
    _Pragma("unroll") for (int e_ = 0; e_ < 4; ++e_) ow[e_] = *(const u32x4*)(lds + G_OT + wid * 4096 + (p0_ + 16 * e_) * 64 + ch_ * 16); } while (0)
#define GFL_STORE(np) do { const int c_ = dir ? NC - 1 - (np) : (np); const long tb_ = (long)seqstart + c_ * 64; \
    const int ch_ = lane_v & 3, p0_ = lane_v >> 2; \
    _Pragma("unroll") for (int e_ = 0; e_ < 4; ++e_) { const int pos_ = p0_ + 16 * e_; \
      const long t_ = tb_ + (dir ? 63 - pos_ : pos_); \
      *(u32x4*)(OUT + t_ * 1024 + h * 256 + 32 * dvb + ch_ * 8) = ow[e_]; } } while (0)
  u32x4 ow[4] = {};
  { const int spos = spos_, sc8 = sc8_, vsr = vsr_, vsc = vsc_; GLOAD(0); }
  for (int n = 0; n < NC; ++n) {
    int tidv = tid; asm volatile("" : "+v"(tidv));
    const int lanev = tidv & 63, r32 = lanev & 31, hi = lanev >> 5, c0 = 2 * lanev, spos = tidv >> 3, sc8 = (tidv & 7) * 8, vsr = tidv >> 4, vsc = (tidv & 15) * 8;
    if (tid < 128) *(bf16x8*)(lds + G_GF + (tid >> 1) * 48 + (tid & 1) * 16) = rg;
    { const int lane_v = r32 | (hi << 5); if (n > 0 && act) GFL_READ(); }
    LBAR();
    {
      const int tm = wid >> 2, tn = wid & 3;
      const bf16x8 ga = *(const bf16x8*)(lds + G_GF + (32 * tm + r32) * 48 + hi * 16);
      const bf16x8 bh = *(const bf16x8*)(lds + G_WG + (32 * tn + r32) * 48 + hi * 16);
      const bf16x8 bl = *(const bf16x8*)(lds + G_WGL + (32 * tn + r32) * 48 + hi * 16);
      f32x16 z = {};
      z = MFMA32(ga, bh, z); z = MFMA32(ga, bl, z);
      float* zl = (float*)(lds + G_OT) + (32 * tm + 4 * hi) * 128 + 32 * tn + r32;
#pragma unroll
      for (int r = 0; r < 16; ++r) {
        const float zz = z[r] + biasm;
        const float e = __builtin_amdgcn_exp2f(fabsf(zz) * -1.4426950408889634f);
        const float l = __builtin_amdgcn_logf(1.f + e);
        zl[((r & 3) + 8 * (r >> 2)) * 128] = (fminf(zz, 0.f) * 1.4426950408889634f - l) * 0.0625f;
      }
    }
    LBAR();
    *(bf16x8*)(lds + G_QD + spos * QDS + sc8 * 2) = rq0; *(bf16x8*)(lds + G_QD + spos * QDS + (sc8 + 64) * 2) = rq1;
    *(bf16x8*)(lds + G_KI + spos * QDS + sc8 * 2) = rk0; *(bf16x8*)(lds + G_KI + spos * QDS + (sc8 + 64) * 2) = rk1;
    *(bf16x8*)(lds + G_VT + v_st(vsr, vsc)) = rv0; *(bf16x8*)(lds + G_VT + v_st(32 + vsr, vsc)) = rv1;
    *(bf16x8*)(lds + G_VT + 16384 + v_st(vsr, vsc)) = rv2; *(bf16x8*)(lds + G_VT + 16384 + v_st(32 + vsr, vsc)) = rv3;
    { const int lane_v = r32 | (hi << 5); if (n > 0 && act) GFL_STORE(n - 1); }
    if (n + 1 < NC) GLOAD(n + 1);
    float bl0[8], bl1[8];
    {
      float run0 = 0.f, run1 = 0.f;
#pragma unroll
      for (int r = 0; r < 8; ++r) {
        const f32x2 t = *(const f32x2*)((const float*)(lds + G_OT) + (8 * g + r) * 128 + c0);
        run0 += t[0]; run1 += t[1]; bl0[r] = run0; bl1[r] = run1;
      }
      *(f32x2*)((float*)(lds + G_GT) + g * 128 + c0) = (f32x2){run0, run1};
    }
    LBAR();
    {
      float pre0 = 0.f, pre1 = 0.f, all0 = 0.f, all1 = 0.f;
#pragma unroll
      for (int gg = 0; gg < 8; ++gg) { const f32x2 t = *(const f32x2*)((const float*)(lds + G_GT) + gg * 128 + c0);
        all0 += t[0]; all1 += t[1]; if (gg < g) { pre0 += t[0]; pre1 += t[1]; } }
      const float ea0 = __builtin_amdgcn_exp2f(all0), ea1 = __builtin_amdgcn_exp2f(all1);
      float kt0[8], kt1[8];
#pragma unroll
      for (int r = 0; r < 8; ++r) {
        const float e0 = __builtin_amdgcn_exp2f(pre0 + bl0[r]), e1 = __builtin_amdgcn_exp2f(pre1 + bl1[r]);
        const float i0 = __builtin_amdgcn_rcpf(e0), i1 = __builtin_amdgcn_rcpf(e1);
        unsigned* qp = (unsigned*)(lds + G_QD + (8 * g + r) * QDS + c0 * 2);
        unsigned* kp = (unsigned*)(lds + G_KI + (8 * g + r) * QDS + c0 * 2);
        const unsigned qw = *qp, kw = *kp;
        const float k0 = bflo(kw) * i0, k1 = bfhi(kw) * i1;
        *qp = pk2(bflo(qw) * GLA_QS * e0, bfhi(qw) * GLA_QS * e1);
        *kp = pk2(k0, k1);
        kt0[r] = k0 * ea0; kt1[r] = k1 * ea1;
      }
      u32x4 w0 = {pk2(kt0[0], kt0[1]), pk2(kt0[2], kt0[3]), pk2(kt0[4], kt0[5]), pk2(kt0[6], kt0[7])};
      u32x4 w1 = {pk2(kt1[0], kt1[1]), pk2(kt1[2], kt1[3]), pk2(kt1[4], kt1[5]), pk2(kt1[6], kt1[7])};
      *(u32x4*)(lds + G_KT + c0 * KTS + g * 16) = w0;
      *(u32x4*)(lds + G_KT + (c0 + 1) * KTS + g * 16) = w1;
      if (g == 0) *(f32x2*)((float*)(lds + G_DEC) + c0) = (f32x2){ea0, ea1};
    }
    LBAR();
    {
      const int l15 = lane & 15, q4 = lane >> 4;
#pragma unroll
      for (int rep = 0; rep < 2; ++rep) {
        const int idx = wid + 8 * rep;
        if (idx < 10) {
          int a, bb;
          if (idx < 4) { a = idx; bb = idx; } else if (idx < 7) { a = 0; bb = idx - 3; } else if (idx < 9) { a = 1; bb = idx - 5; } else { a = 2; bb = 3; }
          const char* kb = lds + G_KI + (16 * a + l15) * QDS + q4 * 16;
          const char* qb = lds + G_QD + (16 * bb + l15) * QDS + q4 * 16;
          f32x4 acc = {0.f, 0.f, 0.f, 0.f};
#pragma unroll
          for (int kk = 0; kk < 4; ++kk)
            acc = __builtin_amdgcn_mfma_f32_16x16x32_bf16(*(const bf16x8*)(kb + kk * 64), *(const bf16x8*)(qb + kk * 64), acc, 0, 0, 0);
          if (a == bb) {
#pragma unroll
            for (int r = 0; r < 4; ++r) if (4 * q4 + r > l15) acc[r] = 0.f;
          }
          *(u32x2*)(lds + G_XS + (16 * bb + l15) * KTS + (16 * a + 4 * q4) * 2) = (u32x2){pk2(acc[0], acc[1]), pk2(acc[2], acc[3])};
        }
      }
    }
    LBAR();
    if (act) {
    f32x16 O0 = {}, O1 = {};
    {
      bf16x8 vb[4];
      {
        const int vbase = (int)(unsigned)(size_t)(LAS char*)(lds + G_VT) + (dvb >> 2) * 16384 + (dvb & 3) * 512 + v_rd_base(r32 | (hi << 5));
        const s16x4 l0 = tr_read<v_rd_off(0, 0, 0)>(vbase), h0 = tr_read<v_rd_off(0, 0, 1)>(vbase), l1 = tr_read<v_rd_off(0, 1, 0)>(vbase), h1 = tr_read<v_rd_off(0, 1, 1)>(vbase);
        const s16x4 l2 = tr_read<v_rd_off(0, 2, 0)>(vbase), h2 = tr_read<v_rd_off(0, 2, 1)>(vbase), l3 = tr_read<v_rd_off(0, 3, 0)>(vbase), h3 = tr_read<v_rd_off(0, 3, 1)>(vbase);
        asm volatile("s_waitcnt lgkmcnt(0)" ::: "memory"); SBAR();
        vb[0] = (bf16x8){l0[0], l0[1], l0[2], l0[3], h0[0], h0[1], h0[2], h0[3]};
        vb[1] = (bf16x8){l1[0], l1[1], l1[2], l1[3], h1[0], h1[1], h1[2], h1[3]};
        vb[2] = (bf16x8){l2[0], l2[1], l2[2], l2[3], h2[0], h2[1], h2[2], h2[3]};
        vb[3] = (bf16x8){l3[0], l3[1], l3[2], l3[3], h3[0], h3[1], h3[2], h3[3]};
      }
      const char* xa0 = lds + G_XS + r32 * KTS + hi * 16;
      const char* xa1 = lds + G_XS + (32 + r32) * KTS + hi * 16;
#pragma unroll
      for (int ks = 0; ks < 2; ++ks) O0 = MFMA32(*(const bf16x8*)(xa0 + ks * 32), vb[ks], O0);
#pragma unroll
      for (int ks = 0; ks < 4; ++ks) O1 = MFMA32(*(const bf16x8*)(xa1 + ks * 32), vb[ks], O1);
#pragma unroll
      for (int dkb = 0; dkb < 4; ++dkb) {
#pragma unroll
        for (int s = 0; s < 2; ++s) {
          const bf16x8 xs = pack8(S[dkb], s);
          const char* qa = lds + G_QD + r32 * QDS + (32 * dkb + 16 * s) * 2 + hi * 8;
          {
            const s16x4 lo = *(const s16x4*)(qa), hh = *(const s16x4*)(qa + 16);
            const bf16x8 pa = {lo[0], lo[1], lo[2], lo[3], hh[0], hh[1], hh[2], hh[3]};
            O0 = MFMA32(pa, xs, O0);
          }
          {
            const s16x4 lo = *(const s16x4*)(qa + 32 * QDS), hh = *(const s16x4*)(qa + 32 * QDS + 16);
            const bf16x8 pa = {lo[0], lo[1], lo[2], lo[3], hh[0], hh[1], hh[2], hh[3]};
            O1 = MFMA32(pa, xs, O1);
          }
        }
      }
      const float* dec = (const float*)(lds + G_DEC);
#pragma unroll
      for (int dkb = 0; dkb < 4; ++dkb) {
#pragma unroll
        for (int q4 = 0; q4 < 4; ++q4) {
          const f32x4 d0 = *(const f32x4*)(dec + 32 * dkb + 8 * q4 + 4 * hi);
#pragma unroll
          for (int j = 0; j < 4; ++j) S[dkb][4 * q4 + j] *= d0[j];
        }
        const char* ka = lds + G_KT + (32 * dkb + r32) * KTS + hi * 16;
#pragma unroll
        for (int ks = 0; ks < 4; ++ks) S[dkb] = MFMA32(*(const bf16x8*)(ka + ks * 32), vb[ks], S[dkb]);
      }
    }
    {
      char* ot = lds + G_OT + wid * 4096 + r32 * 2;
#pragma unroll
      for (int r = 0; r < 16; ++r) {
        const int i0 = crow(r, hi);
        *(short*)(ot + i0 * 64) = (short)(pk2(O0[r], O0[r]) & 0xffffu);
        *(short*)(ot + (32 + i0) * 64) = (short)(pk2(O1[r], O1[r]) & 0xffffu);
      }
    }
    }
  }
  if (act) { const int lane_v = lane; GFL_READ(); GFL_STORE(NC - 1); }
#undef GLOAD
#undef GFL_READ
#undef GFL_STORE
}

DI void phase_kpe(const Params& p) {
  const bf16_t* PS = (const bf16_t*)(p.ws + OFF_PROJS);
  unsigned* KPE = (unsigned*)(p.ws + OFF_KPE);
  const f32x2* tab = (const f32x2*)(p.ws + OFF_ROPE);
  for (int idx = blockIdx.x * 512 + threadIdx.x; idx < T * 32; idx += gridDim.x * 512) {
    const int tok = idx >> 5, i = idx & 31;
    const int pos = tok < TP ? (tok & 4095) : tok - TP;
    const float k1 = bf2f((short)PS[(size_t)tok * 256 + i]), k2 = bf2f((short)PS[(size_t)tok * 256 + 32 + i]);
    const f32x2 cs = tab[pos * 32 + i];
    KPE[idx] = pk2(k1 * cs[0] - k2 * cs[1], k2 * cs[0] + k1 * cs[1]);
  }
}
DI void phase_e0(const Params& p) {
  const int tid = threadIdx.x, lane = tid & 63;
  const bf16_t* PG = (const bf16_t*)(p.ws + OFF_PROJG);
  bf16_t* OF = (bf16_t*)(p.out + DO_OF); const bf16_t* OBk = (const bf16_t*)(p.out + DO_OB);
  const int gw = blockIdx.x * 8 + (tid >> 6), nw = gridDim.x * 8;
  float gn[16];
#pragma unroll
  for (int j = 0; j < 16; ++j) gn[j] = p.gla_norm[(lane & 15) * 16 + j];
  for (int row = gw; row < T; row += nw) {
    const u32x4* a = (const u32x4*)(OF + (size_t)row * 1024 + lane * 16);
    const u32x4* b = (const u32x4*)(OBk + (size_t)row * 1024 + lane * 16);
    const u32x4* gp = (const u32x4*)(PG + (size_t)row * 3072 + 2048 + lane * 16);
    float v[16], gg[16];
#pragma unroll
    for (int q = 0; q < 2; ++q) { const u32x4 x = __builtin_nontemporal_load(a + q), y = __builtin_nontemporal_load(b + q), z = __builtin_nontemporal_load(gp + q);
#pragma unroll
      for (int j = 0; j < 4; ++j) { v[q * 8 + 2 * j] = bflo(x[j]) + bflo(y[j]); v[q * 8 + 2 * j + 1] = bfhi(x[j]) + bfhi(y[j]);
        gg[q * 8 + 2 * j] = bflo(z[j]); gg[q * 8 + 2 * j + 1] = bfhi(z[j]); } }
    float ss = 0.f;
#pragma unroll
    for (int j = 0; j < 16; ++j) ss += v[j] * v[j];
    ss += __shfl_xor(ss, 1); ss += __shfl_xor(ss, 2); ss += __shfl_xor(ss, 4); ss += __shfl_xor(ss, 8);
    const float rs = __builtin_amdgcn_rsqf(ss * (1.0f / 256) + EPS);
    float o[16];
#pragma unroll
    for (int j = 0; j < 16; ++j) { const float s = gg[j] / (1.f + __expf(-gg[j])); o[j] = v[j] * rs * gn[j] * s; }
    u32x4 w0 = {pk2(o[0], o[1]), pk2(o[2], o[3]), pk2(o[4], o[5]), pk2(o[6], o[7])};
    u32x4 w1 = {pk2(o[8], o[9]), pk2(o[10], o[11]), pk2(o[12], o[13]), pk2(o[14], o[15])};
    u32x4* d = (u32x4*)(OF + (size_t)row * 1024 + lane * 16);
    d[0] = w0; d[1] = w1;
  }
}
DI void phase_combine(const Params& p) {
  const int tid = threadIdx.x, lane = tid & 63;
  bf16_t* MO = (bf16_t*)(p.ws + OFF_PROJA);
  const bf16_t* P1 = (const bf16_t*)(p.out + DO_P1);
  const float* L0 = (const float*)(p.out + DO_LSE); const float* L1 = L0 + 8 * N_SSPLIT * 256;
  const int gw = blockIdx.x * 8 + (tid >> 6), nw = gridDim.x * 8;
  for (int j = gw; j < 8 * N_SSPLIT * 256; j += nw) {
    const int si = j >> 8, h = si / N_SSPLIT, blk = 64 - N_SSPLIT + (si % N_SSPLIT);
    const long row = (long)TP + blk * 256 + (j & 255);
    const float l0 = L0[j], l1 = L1[j], m = fmaxf(l0, l1);
    const float w0 = __builtin_amdgcn_exp2f(l0 - m), w1 = __builtin_amdgcn_exp2f(l1 - m), inv = __builtin_amdgcn_rcpf(w0 + w1);
    unsigned* d = (unsigned*)(MO + row * 1024 + h * 128) + lane;
    const unsigned a = *d, b = ((const unsigned*)(P1 + (long)j * 1024))[lane];
    *d = pk2((w0 * bflo(a) + w1 * bflo(b)) * inv, (w0 * bfhi(a) + w1 * bfhi(b)) * inv);
  }
}
DI void phase_e1(const Params& p) {
  const int tid = threadIdx.x, lane = tid & 63;
  const bf16_t* MIX = (const bf16_t*)(p.ws + OFF_MIX);
  bf16_t* XB1 = (bf16_t*)(p.ws + OFF_XB);
  float* X1 = (float*)p.out; float* rs2 = (float*)(p.ws + OFF_RS2);
  const float* ssqm = (const float*)(p.ws + OFF_SSQM);
  const int gw = blockIdx.x * 8 + (tid >> 6), nw = gridDim.x * 8;
  f32x4 gv[8];
#pragma unroll
  for (int i = 0; i < 8; ++i) gv[i] = *(const f32x4*)(p.post_mix + (i * 64 + lane) * 4);
  for (int row0 = gw; row0 < T; row0 += 2 * nw) {
    const int row1 = row0 + nw;
    const float* src0 = row0 < TP ? p.x0 + (size_t)row0 * DM : p.x1 + (size_t)(row0 - TP) * DM;
    const float* src1 = row1 < TP ? p.x0 + (size_t)row1 * DM : p.x1 + (size_t)(row1 - TP) * DM;
    float sp0 = lane < 32 ? ssqm[(size_t)row0 * 32 + lane] : 0.f, sp1 = lane < 32 ? ssqm[(size_t)row1 * 32 + lane] : 0.f;
    f32x4 xa[8], xb[8]; u32x2 ma[8], mb[8];
#pragma unroll
    for (int i = 0; i < 8; ++i) { const int c = (i * 64 + lane) * 4;
      xa[i] = __builtin_nontemporal_load((const f32x4*)(src0 + c)); ma[i] = __builtin_nontemporal_load((const u32x2*)(MIX + (size_t)row0 * DM + c));
      xb[i] = __builtin_nontemporal_load((const f32x4*)(src1 + c)); mb[i] = __builtin_nontemporal_load((const u32x2*)(MIX + (size_t)row1 * DM + c)); }
    sp0 = wave_sum(sp0); sp1 = wave_sum(sp1);
    const float ra = __builtin_amdgcn_rsqf(sp0 * (1.0f / DM) + EPS), rb = __builtin_amdgcn_rsqf(sp1 * (1.0f / DM) + EPS);
    float sa = 0.f, sb = 0.f;
#pragma unroll
    for (int i = 0; i < 8; ++i) { const int c = (i * 64 + lane) * 4;
      f32x4 y, z;
      y[0] = xa[i][0] + bflo(ma[i][0]) * ra * gv[i][0]; y[1] = xa[i][1] + bfhi(ma[i][0]) * ra * gv[i][1];
      y[2] = xa[i][2] + bflo(ma[i][1]) * ra * gv[i][2]; y[3] = xa[i][3] + bfhi(ma[i][1]) * ra * gv[i][3];
      z[0] = xb[i][0] + bflo(mb[i][0]) * rb * gv[i][0]; z[1] = xb[i][1] + bfhi(mb[i][0]) * rb * gv[i][1];
      z[2] = xb[i][2] + bflo(mb[i][1]) * rb * gv[i][2]; z[3] = xb[i][3] + bfhi(mb[i][1]) * rb * gv[i][3];
      sa += y[0] * y[0] + y[1] * y[1] + y[2] * y[2] + y[3] * y[3];
      sb += z[0] * z[0] + z[1] * z[1] + z[2] * z[2] + z[3] * z[3];
      u32x2 w0 = {pk2(y[0], y[1]), pk2(y[2], y[3])}, w1 = {pk2(z[0], z[1]), pk2(z[2], z[3])};
      *(u32x2*)(XB1 + (size_t)row0 * DM + c) = w0; *(u32x2*)(XB1 + (size_t)row1 * DM + c) = w1; }
    sa = wave_sum(sa); sb = wave_sum(sb);
    if (lane == 0) { rs2[row0] = __builtin_amdgcn_rsqf(sa * (1.0f / DM) + EPS); rs2[row1] = __builtin_amdgcn_rsqf(sb * (1.0f / DM) + EPS); }
  }
}
DI void phase_e2(const Params& p) {
  const int tid = threadIdx.x, lane = tid & 63;
  const bf16_t* XB1 = (const bf16_t*)(p.ws + OFF_XB);
  float* OUT = (float*)p.out;
  const float* ssqm = (const float*)(p.ws + OFF_SSQM);
  const int gw = blockIdx.x * 8 + (tid >> 6), nw = gridDim.x * 8;
  f32x4 gv[8];
#pragma unroll
  for (int i = 0; i < 8; ++i) gv[i] = *(const f32x4*)(p.post_mlp + (i * 64 + lane) * 4);
  for (int row0 = gw; row0 < T; row0 += 2 * nw) {
    const int row1 = row0 + nw;
    float sp0 = lane < 32 ? ssqm[(size_t)row0 * 32 + lane] : 0.f, sp1 = lane < 32 ? ssqm[(size_t)row1 * 32 + lane] : 0.f;
    u32x2 xa[8], xb[8], fa[8], fb[8];
#pragma unroll
    for (int i = 0; i < 8; ++i) { const int c = (i * 64 + lane) * 4;
      xa[i] = __builtin_nontemporal_load((const u32x2*)(XB1 + (size_t)row0 * DM + c)); fa[i] = __builtin_nontemporal_load((const u32x2*)((const bf16_t*)(OUT + (size_t)row0 * DM) + c));
      xb[i] = __builtin_nontemporal_load((const u32x2*)(XB1 + (size_t)row1 * DM + c)); fb[i] = __builtin_nontemporal_load((const u32x2*)((const bf16_t*)(OUT + (size_t)row1 * DM) + c)); }
    sp0 = wave_sum(sp0); sp1 = wave_sum(sp1);
    const float ra = __builtin_amdgcn_rsqf(sp0 * (1.0f / DM) + EPS), rb = __builtin_amdgcn_rsqf(sp1 * (1.0f / DM) + EPS);
    f32x4 ya[8], yb[8];
#pragma unroll
    for (int i = 0; i < 8; ++i) {
      ya[i][0] = bflo(xa[i][0]) + bflo(fa[i][0]) * ra * gv[i][0]; ya[i][1] = bfhi(xa[i][0]) + bfhi(fa[i][0]) * ra * gv[i][1];
      ya[i][2] = bflo(xa[i][1]) + bflo(fa[i][1]) * ra * gv[i][2]; ya[i][3] = bfhi(xa[i][1]) + bfhi(fa[i][1]) * ra * gv[i][3];
      yb[i][0] = bflo(xb[i][0]) + bflo(fb[i][0]) * rb * gv[i][0]; yb[i][1] = bfhi(xb[i][0]) + bfhi(fb[i][0]) * rb * gv[i][1];
      yb[i][2] = bflo(xb[i][1]) + bflo(fb[i][1]) * rb * gv[i][2]; yb[i][3] = bfhi(xb[i][1]) + bfhi(fb[i][1]) * rb * gv[i][3]; }
    asm volatile("s_waitcnt vmcnt(0)" ::: "memory");
#pragma unroll
    for (int i = 0; i < 8; ++i) { const int c = (i * 64 + lane) * 4;
      __builtin_nontemporal_store(ya[i], (f32x4*)(OUT + (size_t)row0 * DM + c)); __builtin_nontemporal_store(yb[i], (f32x4*)(OUT + (size_t)row1 * DM + c)); }
  }
}

DI void phase_mixer(const Params& p, char* lds) {
  unsigned* ctr = (unsigned*)(p.ws + OFF_CTR);
  int* sh = (int*)(lds + 157696);
  const bf16_t* Q = (const bf16_t*)(p.out + DO_Q);
  const bf16_t* KV = (const bf16_t*)(p.ws + OFF_XB);
  const bf16_t* KPE = (const bf16_t*)(p.ws + OFF_KPE);
  bf16_t* MO = (bf16_t*)(p.ws + OFF_PROJA);
  const int xcd = blockIdx.x & 7;
  for (int d = 0; d < 8; ++d) {
    const int y = (xcd + d) & 7;
    for (;;) {
      __syncthreads();
      if (threadIdx.x == 0) *sh = (int)atomicAdd(ctr + 32 * y, 1u);
      __syncthreads();
      const int v = *sh;
      if (v >= 6) break;
#ifndef NO_GLA
      gla_task(p, v < 2 ? 2 * y + v : 16 + 4 * y + (v - 2), lds);
#endif
    }
  }
  for (int d = 0; d < 8; ++d) {
    const int y = (xcd + d) & 7;
    for (;;) {
      __syncthreads();
      if (threadIdx.x == 0) *sh = (int)atomicAdd(ctr + 256 + 32 * y, 1u);
      __syncthreads();
      const int v = *sh;
      if (v >= N_ATTQ) break;
      int seqstart, len, blk, kbeg = 0; float* lse = nullptr; const int h = y;
      bf16_t* ob = nullptr;
      if (v < 64 - N_SSPLIT) { seqstart = TP; len = 16384; blk = v; }
      else if (v < 64 + N_SSPLIT) {
        const int w = v - (64 - N_SSPLIT), i = w >> 1, half = w & 1, si = y * N_SSPLIT + i;
        seqstart = TP; len = 8192; kbeg = half * 8192; blk = 64 - N_SSPLIT + i;
        lse = (float*)(p.out + DO_LSE) + half * (8 * N_SSPLIT * 256) + si * 256;
        if (half) ob = (bf16_t*)(p.out + DO_P1) + (long)si * 256 * 1024;
      } else { const int v2 = v - (64 + N_SSPLIT); seqstart = (v2 >> 4) * 4096; len = 4096; blk = v2 & 15; }
      const long q0 = (long)seqstart + blk * 256, k0 = (long)seqstart + kbeg;
      if (ob == nullptr) ob = MO + q0 * 1024 + h * 128;
#ifndef NO_ATT
      attn_unit(Q + q0 * 1536 + h * 192, KV + k0 * 2048 + h * 256, KV + k0 * 2048 + h * 256 + 128, KPE + k0 * 64, ob, len, lse, lds);
#endif
    }
  }
  for (;;) {
    __syncthreads();
    if (threadIdx.x == 0) *sh = (int)atomicAdd(ctr + 512, 4u);
    __syncthreads();
    const int t0 = *sh;
    if (t0 >= N_LATE) break;
    conv_late_tile4(p, t0, lds);
  }
}

DI void gbar(unsigned* bar, unsigned k, char* lds) {
  asm volatile("s_waitcnt vmcnt(0)" ::: "memory");
  __syncthreads();
  if (threadIdx.x == 0) {
    volatile unsigned* st = (volatile unsigned*)(lds + 157696 + 64);
    const unsigned x = (unsigned)__builtin_amdgcn_s_getreg((3 << 11) | 20) & 0xFu;
    unsigned nloc, nx;
    if (k == 1u) {
      unsigned spins = 0;
      for (;;) {
        unsigned sum = 0, cnt = 0, mine = 0;
        for (unsigned j = 0; j < 16; ++j) { const unsigned c = __hip_atomic_load(bar + 2048 + 64 * j, __ATOMIC_RELAXED, __HIP_MEMORY_SCOPE_AGENT); sum += c; cnt += c ? 1u : 0u; mine = j == x ? c : mine; }
        nloc = mine ? mine : 1u; nx = cnt ? cnt : 1u;
        if (sum == gridDim.x || ++spins > (1u << 20)) break;
        __builtin_amdgcn_s_sleep(1);
      }
      st[0] = nloc; st[1] = nx;
    } else { nloc = st[0]; nx = st[1]; }
    const unsigned old = __hip_atomic_fetch_add(bar + 128 + 64 * x, 1u, __ATOMIC_RELAXED, __HIP_MEMORY_SCOPE_AGENT);
    if (old + 1u == k * nloc) {
      __builtin_amdgcn_fence(__ATOMIC_RELEASE, "agent");
      asm volatile("s_waitcnt vmcnt(0)" ::: "memory");
      const unsigned og = __hip_atomic_fetch_add(bar, 1u, __ATOMIC_RELAXED, __HIP_MEMORY_SCOPE_AGENT);
      if (og + 1u == k * nx) __hip_atomic_store(bar + 64, k, __ATOMIC_RELAXED, __HIP_MEMORY_SCOPE_AGENT);
    }
    { unsigned spins = 0; while (__hip_atomic_load(bar + 64, __ATOMIC_RELAXED, __HIP_MEMORY_SCOPE_AGENT) < k) { __builtin_amdgcn_s_sleep(1); if (++spins > (1u << 22)) break; } }
    __builtin_amdgcn_fence(__ATOMIC_ACQUIRE, "agent");
    asm volatile("s_waitcnt vmcnt(0)" ::: "memory");
  }
  __syncthreads();
}

__global__ void __launch_bounds__(512) mega(Params p, int ph_lo, int ph_hi) {
  extern __shared__ __attribute__((aligned(16))) char lds[];
  cg::grid_group grid = cg::this_grid();
#ifndef PH_MASK
#define PH_MASK 0xfff
#endif
#define PHASE(k, ...) if (((PH_MASK >> k) & 1) && ph_lo <= k && k < ph_hi) { if (k == 1) { grid.sync(); if (threadIdx.x == 0) __hip_atomic_fetch_add((unsigned*)(p.ws + OFF_CTR) + 1024 + 2048 + 64 * ((unsigned)__builtin_amdgcn_s_getreg((3 << 11) | 20) & 0xFu), 1u, __ATOMIC_RELAXED, __HIP_MEMORY_SCOPE_AGENT); } else if (k > 1) gbar((unsigned*)(p.ws + OFF_CTR) + 1024, (unsigned)(k - 1), lds); __VA_ARGS__; }
  PHASE(0, phase0(p, lds))
  PHASE(1, run_gemm<EP_IN>(p, lds, (const bf16_t*)(p.ws + OFF_XB), 2048, (const bf16_t*)(p.ws + OFF_WIN), T, NIN_PAD, 2048, 0); conv_idle_round(p, lds))
  PHASE(2, run_gemm<EP_Q>(p, lds, (const bf16_t*)(p.ws + OFF_PROJA), 1024, (const bf16_t*)(p.ws + OFF_WQB), T, 1536, 512, 0);
           run_gemm<EP_KV>(p, lds, (const bf16_t*)(p.ws + OFF_PROJA) + 512, 1024, (const bf16_t*)(p.ws + OFF_WKVB), T, 2048, 512, 0))
  PHASE(3, phase_mixer(p, lds))
  PHASE(4, phase_combine(p); phase_e0(p))
  PHASE(5, run_gemm<EP_MIX>(p, lds, (const bf16_t*)(p.ws + OFF_PROJA), 1024, (const bf16_t*)(p.ws + OFF_WOUT), T, 2048, 2048, 0,
                            (long)((p.out + DO_OF) - (p.ws + OFF_PROJA)) - 2048, 16))
  PHASE(6, phase_e1(p))
  PHASE(7, run_gemm<EP_UP>(p, lds, (const bf16_t*)(p.ws + OFF_XB), 2048, (const bf16_t*)(p.ws + OFF_WUP), TP, DFF, 2048, 0))
  PHASE(8, run_gemm<EP_DOWN>(p, lds, (const bf16_t*)(p.ws + OFF_U), 8192, (const bf16_t*)(p.ws + OFF_WDOWN), TP, 2048, 8192, 0))
  PHASE(9, run_gemm<EP_UP>(p, lds, (const bf16_t*)(p.ws + OFF_XB) + (size_t)TP * 2048, 2048, (const bf16_t*)(p.ws + OFF_WUP), TP, DFF, 2048, TP))
  PHASE(10, run_gemm<EP_DOWN>(p, lds, (const bf16_t*)(p.ws + OFF_U), 8192, (const bf16_t*)(p.ws + OFF_WDOWN), TP, 2048, 8192, TP))
  PHASE(11, phase_e2(p))
}

extern "C" void kernel_launch(void* const* d_in, const int* in_sizes, int n_in, void* d_out, int out_size,
                              void* d_ws, size_t ws_size, hipStream_t stream) {
  static int grid_blocks = 0;
  if (!grid_blocks) {
    if (hipFuncSetAttribute((const void*)mega, hipFuncAttributeMaxDynamicSharedMemorySize, LDS_BYTES) != hipSuccess) fprintf(stderr, "set attr failed\n");
    int dev = 0, cus = 0, per_cu = 0;
    (void)hipGetDevice(&dev);
    (void)hipDeviceGetAttribute(&cus, hipDeviceAttributeMultiprocessorCount, dev);
    (void)hipOccupancyMaxActiveBlocksPerMultiprocessor(&per_cu, mega, 512, LDS_BYTES);
    if (per_cu < 1) { fprintf(stderr, "occupancy query returned %d\n", per_cu); per_cu = 1; }
    grid_blocks = cus;
  }
  if (n_in != 19 || ws_size < WS_NEED || out_size != T * DM) { fprintf(stderr, "kernel_launch: unexpected sizes n_in %d ws %zu out %d\n", n_in, ws_size, out_size); return; }
  Params p{};
  const float** pp = (const float**)&p;
  for (int i = 0; i < 19; ++i) pp[i] = (const float*)d_in[i];
  p.out = (char*)d_out; p.ws = (char*)d_ws;
  int lo = 0, hi = 12;
  void* args[] = {&p, &lo, &hi};
  hipError_t e = hipLaunchCooperativeKernel((void*)mega, dim3(grid_blocks), dim3(512), args, LDS_BYTES, stream);
  if (e != hipSuccess) fprintf(stderr, "cooperative launch failed: %s (grid %d)\n", hipGetErrorString(e), grid_blocks);
}
```

```cpp
#include <hip/hip_runtime.h>
#include <hip/hip_cooperative_groups.h>
#include <cstdio>
namespace cg = cooperative_groups;

#define DI __device__ __forceinline__
#define LAS __attribute__((address_space(3)))
typedef unsigned short bf16_t;
typedef short bf16x8 __attribute__((ext_vector_type(8)));
typedef short s16x4 __attribute__((ext_vector_type(4)));
typedef float f32x2 __attribute__((ext_vector_type(2)));
typedef float f32x4 __attribute__((ext_vector_type(4)));
typedef float f32x16 __attribute__((ext_vector_type(16)));
typedef unsigned u32x2 __attribute__((ext_vector_type(2)));
typedef unsigned u32x4 __attribute__((ext_vector_type(4)));
typedef __bf16 bfv2 __attribute__((ext_vector_type(2)));

constexpr int T = 32768, TP = 16384, DM = 2048, DFF = 8192;
constexpr float EPS = 1e-6f;
constexpr int NIN_PAD = 4352;
constexpr float QSCALE = 0.07216878364870323f * 1.4426950408889634f;
constexpr float GLA_QS = 0.08838834764831845f;

constexpr size_t MiB = 1u << 20;
constexpr size_t OFF_WIN = 0, OFF_WQB = 17 * MiB, OFF_WKVB = OFF_WQB + 3 * MiB / 2, OFF_WOUT = OFF_WKVB + 2 * MiB,
                 OFF_WUP = OFF_WOUT + 8 * MiB, OFF_WDOWN = OFF_WUP + 32 * MiB;
constexpr size_t OFF_RS0 = 93 * MiB, OFF_RS2 = OFF_RS0 + 128 * 1024, OFF_CTR = OFF_RS2 + 128 * 1024,
                 OFF_SSQA = 94 * MiB, OFF_SSQM = 96 * MiB, OFF_ROPE = 100 * MiB;
constexpr size_t OFF_PROJG = 104 * MiB;
constexpr size_t OFF_PROJS = 296 * MiB;
constexpr size_t OFF_PROJA = 312 * MiB;
constexpr size_t OFF_XB = 376 * MiB;
constexpr size_t OFF_KPE = 504 * MiB;
constexpr size_t OFF_MIX = 104 * MiB;
constexpr size_t OFF_U = 104 * MiB;
constexpr size_t WS_NEED = 512 * MiB;
constexpr size_t DO_Q = 0, DO_OF = 96 * MiB, DO_OB = 160 * MiB, DO_P1 = 224 * MiB, DO_LSE = 240 * MiB;

constexpr int LDS_BYTES = 157696 + 512;
constexpr int N_IDLE_LATE = 4 * 656;
constexpr int N_SSPLIT = 4, N_ATTQ = 64 + N_SSPLIT + 64;

struct Params {
  const float *x0, *x1, *w_in, *q_a_norm, *w_q_b, *kv_a_norm, *w_kv_b, *w_gk_f, *b_gk_f, *w_gk_b, *b_gk_b, *gla_norm, *w_out,
      *pre_mix, *post_mix, *pre_mlp, *post_mlp, *w_up, *w_down;
  char* out; char* ws;
};

__device__ const double ROPE_INV[32] = {
1.0, 0.7498942093324559, 0.5623413251903491, 0.4216965034285823,
0.31622776601683794, 0.23713737056616555, 0.1778279410038923, 0.1333521432163324,
0.1, 0.07498942093324558, 0.056234132519034905, 0.042169650342858224,
0.03162277660168379, 0.02371373705661655, 0.01778279410038923, 0.01333521432163324,
0.01, 0.007498942093324559, 0.005623413251903491, 0.004216965034285823,
0.00316227766016838, 0.0023713737056616554, 0.001778279410038923, 0.001333521432163324,
0.001, 0.0007498942093324559, 0.0005623413251903491, 0.0004216965034285823,
0.00031622776601683794, 0.00023713737056616554, 0.0001778279410038923, 0.0001333521432163324};

DI unsigned pk2(float a, float b) { f32x2 v = {a, b}; bfv2 r = __builtin_convertvector(v, bfv2); return __builtin_bit_cast(unsigned, r); }
DI float bflo(unsigned w) { return __uint_as_float(w << 16); }
DI float bfhi(unsigned w) { return __uint_as_float(w & 0xffff0000u); }
DI float bf2f(short h) { return __uint_as_float(((unsigned)(unsigned short)h) << 16); }
DI float wave_sum(float v) {
#pragma unroll
  for (int o = 32; o > 0; o >>= 1) v += __shfl_xor(v, o);
  return v;
}
DI int crow(int r, int hi) { return (r & 3) + 8 * (r >> 2) + 4 * hi; }
DI bf16x8 pack8(const f32x16& x, int s) {
  u32x4 w = {pk2(x[8 * s + 0], x[8 * s + 1]), pk2(x[8 * s + 2], x[8 * s + 3]), pk2(x[8 * s + 4], x[8 * s + 5]), pk2(x[8 * s + 6], x[8 * s + 7])};
  return __builtin_bit_cast(bf16x8, w);
}
#define MFMA32(a, b, c) __builtin_amdgcn_mfma_f32_32x32x16_bf16((a), (b), (c), 0, 0, 0)

DI int colmap_in(int n) {
  if (n < 1024) return n;
  if (n < 3072) return n + 64;
  if (n < 4096) return n + 96;
  if (n < 4160) return 1024 + (n - 4096);
  if (n < 4192) return 3136 + (n - 4160);
  return -1;
}
DI int colmap_qb(int n) {
  if (n < 1024) return (n >> 7) * 192 + (n & 127);
  const int m = n - 1024, h = m >> 6, r = m & 63;
  return h * 192 + 128 + (r >> 1) + 32 * (r & 1);
}
template <int CM>
DI void convT_tile(const float* __restrict__ src, int ldsrc, const float* __restrict__ gain, bf16_t* __restrict__ dst, int K, int k0, int n0, float* tile) {
  const int tid = threadIdx.x;
  {
    const int nn = tid & 63, kk0 = tid >> 6;
    const int n = n0 + nn;
    const int sc = CM == 1 ? colmap_in(n) : (CM == 2 ? colmap_qb(n) : n);
#pragma unroll
    for (int r = 0; r < 8; ++r) {
      const int kk = kk0 + 8 * r;
      float v = 0.f;
      if (sc >= 0) { v = src[(size_t)(k0 + kk) * ldsrc + sc]; if (gain) v *= gain[k0 + kk]; }
      tile[kk * 65 + nn] = v;
    }
  }
  __syncthreads();
  {
    const int kk8 = (tid & 7) * 8, n2 = tid >> 3;
    float v[8];
#pragma unroll
    for (int j = 0; j < 8; ++j) v[j] = tile[(kk8 + j) * 65 + n2];
    u32x4 w = {pk2(v[0], v[1]), pk2(v[2], v[3]), pk2(v[4], v[5]), pk2(v[6], v[7])};
    *(u32x4*)(dst + (size_t)(n0 + n2) * K + k0 + kk8) = w;
  }
  __syncthreads();
}

template <int CM>
DI void convT_tile4(const float* __restrict__ src, int ldsrc, const float* __restrict__ gain, bf16_t* __restrict__ dst, int K, int k0, int n0, float* tile) {
  const int tid = threadIdx.x;
  const int nn = tid & 63, kk0 = tid >> 6;
  const int sc = CM == 1 ? colmap_in(n0 + nn) : (CM == 2 ? colmap_qb(n0 + nn) : n0 + nn);
  float v[4][8];
#pragma unroll
  for (int t = 0; t < 4; ++t)
#pragma unroll
    for (int r = 0; r < 8; ++r) v[t][r] = sc >= 0 ? __builtin_nontemporal_load(src + (size_t)(k0 + 64 * t + kk0 + 8 * r) * ldsrc + sc) : 0.f;
  if (gain) {
#pragma unroll
    for (int t = 0; t < 4; ++t)
#pragma unroll
      for (int r = 0; r < 8; ++r) v[t][r] *= gain[k0 + 64 * t + kk0 + 8 * r];
  }
  const int kk8 = (tid & 7) * 8, n2 = tid >> 3;
#pragma unroll
  for (int t = 0; t < 4; ++t) {
#pragma unroll
    for (int r = 0; r < 8; ++r) tile[(kk0 + 8 * r) * 65 + nn] = v[t][r];
    __syncthreads();
    float w[8];
#pragma unroll
    for (int j = 0; j < 8; ++j) w[j] = tile[(kk8 + j) * 65 + n2];
    u32x4 o = {pk2(w[0], w[1]), pk2(w[2], w[3]), pk2(w[4], w[5]), pk2(w[6], w[7])};
    *(u32x4*)(dst + (size_t)(n0 + n2) * K + k0 + 64 * t + kk8) = o;
    __syncthreads();
  }
}

DI void phase0(const Params& p, char* lds) {
  const int tid = threadIdx.x, lane = tid & 63;
  char* ws = p.ws;
  if (blockIdx.x == 0) { for (int i = tid; i < 544; i += 512) ((unsigned*)(ws + OFF_CTR))[i] = i == 512 ? (unsigned)N_IDLE_LATE : 0u; for (int i = tid; i < 3200; i += 512) ((unsigned*)(ws + OFF_CTR))[1024 + i] = 0u; }
  {
    f32x2* tab = (f32x2*)(ws + OFF_ROPE);
    for (int idx = blockIdx.x * 512 + tid; idx < 16384 * 32; idx += gridDim.x * 512) {
      const int pos = idx >> 5, i = idx & 31;
      const double ang = (double)pos * ROPE_INV[i];
      const double kq = __builtin_rint(ang * 0.6366197723675814);
      double r = ang - kq * 1.5707963267948966;
      r = r - kq * 6.123233995736766e-17;
      const double r2 = r * r;
      double sn = r * (1.0 + r2 * (-1.0 / 6 + r2 * (1.0 / 120 + r2 * (-1.0 / 5040 + r2 * (1.0 / 362880 + r2 * (-1.0 / 39916800 + r2 * (1.0 / 6227020800.0)))))));
      double cs = 1.0 + r2 * (-0.5 + r2 * (1.0 / 24 + r2 * (-1.0 / 720 + r2 * (1.0 / 40320 + r2 * (-1.0 / 3628800 + r2 * (1.0 / 479001600.0 + r2 * (-1.0 / 87178291200.0)))))));
      const int q = ((int)kq) & 3;
      double c, s;
      if (q == 0) { c = cs; s = sn; } else if (q == 1) { c = -sn; s = cs; } else if (q == 2) { c = -cs; s = -sn; } else { c = sn; s = -cs; }
      tab[idx] = (f32x2){(float)c, (float)s};
    }
  }
  {
    bf16_t* XB = (bf16_t*)(ws + OFF_XB);
    float* rs0 = (float*)(ws + OFF_RS0);
    const int gw = blockIdx.x * 8 + (tid >> 6), nw = gridDim.x * 8;
    for (int row0 = gw; row0 < T; row0 += 2 * nw) {
      const int row1 = row0 + nw;
      const float* src0 = row0 < TP ? p.x0 + (size_t)row0 * DM : p.x1 + (size_t)(row0 - TP) * DM;
      const float* src1 = row1 < TP ? p.x0 + (size_t)row1 * DM : p.x1 + (size_t)(row1 - TP) * DM;
      f32x4 va[8], vb[8];
#pragma unroll
      for (int i = 0; i < 8; ++i) { va[i] = __builtin_nontemporal_load((const f32x4*)(src0 + (i * 64 + lane) * 4)); vb[i] = __builtin_nontemporal_load((const f32x4*)(src1 + (i * 64 + lane) * 4)); }
      float sa = 0.f, sb = 0.f;
#pragma unroll
      for (int i = 0; i < 8; ++i) {
        sa += va[i][0] * va[i][0] + va[i][1] * va[i][1] + va[i][2] * va[i][2] + va[i][3] * va[i][3];
        sb += vb[i][0] * vb[i][0] + vb[i][1] * vb[i][1] + vb[i][2] * vb[i][2] + vb[i][3] * vb[i][3];
        u32x2 w0 = {pk2(va[i][0], va[i][1]), pk2(va[i][2], va[i][3])}, w1 = {pk2(vb[i][0], vb[i][1]), pk2(vb[i][2], vb[i][3])};
        *(u32x2*)(XB + (size_t)row0 * DM + (i * 64 + lane) * 4) = w0;
        *(u32x2*)(XB + (size_t)row1 * DM + (i * 64 + lane) * 4) = w1;
      }
      sa = wave_sum(sa); sb = wave_sum(sb);
      if (lane == 0) { rs0[row0] = __builtin_amdgcn_rsqf(sa * (1.0f / DM) + EPS); rs0[row1] = __builtin_amdgcn_rsqf(sb * (1.0f / DM) + EPS); }
    }
  }
  {
    float* tile = (float*)lds;
    constexpr int NT = 32 * 68 / 4;
    for (int t = blockIdx.x; t < NT; t += gridDim.x) { const int u = 4 * t;
      convT_tile4<1>(p.w_in, 4192, p.pre_mix, (bf16_t*)(ws + OFF_WIN), 2048, (u & 31) * 64, (u >> 5) * 64, tile); }
  }
}
constexpr int NL3 = 32 * 32, NL4 = 32 * 128, NL5 = 128 * 32, N_LATE = NL3 + NL4 + NL5;
DI void conv_late_tile4(const Params& p, int t, char* lds) {
  float* tile = (float*)lds; char* ws = p.ws;
  int u = t;
  if (u < NL3) { convT_tile4<0>(p.w_out, 2048, nullptr, (bf16_t*)(ws + OFF_WOUT), 2048, (u & 31) * 64, (u >> 5) * 64, tile); return; }
  u -= NL3;
  if (u < NL4) { convT_tile4<0>(p.w_up, 8192, p.pre_mlp, (bf16_t*)(ws + OFF_WUP), 2048, (u & 31) * 64, (u >> 5) * 64, tile); return; }
  u -= NL4;
  convT_tile4<0>(p.w_down, 2048, nullptr, (bf16_t*)(ws + OFF_WDOWN), 8192, (u & 127) * 64, (u >> 7) * 64, tile);
}

DI void conv_idle_round(const Params& p, char* lds) {
  if (blockIdx.x < 128) return;
  float* tile = (float*)lds; char* ws = p.ws;
  __syncthreads();
  for (int g = (int)blockIdx.x - 128; g < 768; g += (int)gridDim.x - 128) {
    if (g < 48) { const int u = 4 * g; convT_tile4<2>(p.w_q_b, 1536, p.q_a_norm, (bf16_t*)(ws + OFF_WQB), 512, (u & 7) * 64, (u >> 3) * 64, tile); }
    else if (g < 112) { const int u = 4 * (g - 48); convT_tile4<0>(p.w_kv_b, 2048, p.kv_a_norm, (bf16_t*)(ws + OFF_WKVB), 512, (u & 7) * 64, (u >> 3) * 64, tile); }
    else conv_late_tile4(p, 4 * (g - 112), lds);
  }
}

namespace pg8 {
constexpr int BM = 256, BK = 64, HALF = 128, HTB = HALF * BK * 2, STAGE_BYTES = 8 * HTB, NXCD = 8, WGM = 8;
DI int lds_byte(int r, int c) { const int st = (r >> 4) * 2 + (c >> 5), rr = r & 15, cc = c & 31, ob = rr * 64 + cc * 2; return st * 1024 + (ob ^ (((ob >> 9) & 1) << 5)); }
DI void stage_rc(int b, int& R, int& C) { const int st = b / 1024, sb = b % 1024, swz = sb ^ (((sb >> 9) & 1) << 5); R = (st >> 1) * 16 + swz / 64; C = (st & 1) * 32 + (swz % 64) / 2; }
DI int perm32(int rho) { const int n = rho >> 4, i = rho & 15; return 8 * (i >> 2) + 4 * n + (i & 3); }
struct Unit { int pm, pn; };
struct Gemm { const bf16_t* A; const bf16_t* Bt; int M, N, K, lda; long segd; int tsplit; };
struct StaticOrder {
  int nM, nN, nwg, G, c, wgm;
  DI void init(int M, int N, int G_, int c_, int wgm_ = WGM) { nM = M / BM; nN = N / BM; nwg = nM * nN; G = G_; c = c_; wgm = wgm_; }
  DI bool next(int i, Unit& u) const {
    const long L = (long)i * G + c; if (L >= nwg) return false;
    int wgid = (int)L; { const int q = nwg / NXCD, r = nwg % NXCD, xcd = wgid % NXCD, off = wgid / NXCD; wgid = (xcd < r ? xcd * (q + 1) : r * (q + 1) + (xcd - r) * q) + off; }
    const int nig = wgm * nN, gid = wgid / nig, fm = gid * wgm, gsz = (nM - fm) < wgm ? (nM - fm) : wgm;
    u.pm = fm + ((wgid % nig) % gsz); u.pn = (wgid % nig) / gsz; return true;
  }
};

template <class Epi>
DI void gemm_phase(LAS unsigned char* lds, const Gemm g, const StaticOrder& S, const Epi& E) {
  const int tid = threadIdx.x, wid = __builtin_amdgcn_readfirstlane(tid >> 6), lane = tid & 63, wr = wid >> 2, wc = wid & 3, fr = lane & 15, fq = lane >> 4;
  const int K = g.K, nt = K / BK, lda = g.lda;
  unsigned voffA[2], voffB[2];
#pragma unroll
  for (int i = 0; i < 2; ++i) { int R, C; stage_rc(tid * 16 + i * 8192, R, C); const int Rb = (R & ~31) + perm32(R & 31);
    voffA[i] = (unsigned)(R * lda + C) * 2u; voffB[i] = (unsigned)(Rb * K + C) * 2u; }
  const size_t kstep = (size_t)(BK * 2);
  const size_t hstepA = (size_t)HALF * lda * 2, hstepB = (size_t)HALF * K * 2;
  const size_t tstepA = 2 * hstepA, tstepB = 2 * hstepB;
  const unsigned ldsw = (unsigned)wid * 1024u;
  const int aoff = lds_byte(wr * 64 + fr, fq * 8), boff = lds_byte(wc * 32 + fr, fq * 8);
  const int tsplit = g.tsplit; const long segd = g.segd;
#define PG8_AK(t) ((size_t)(t) * kstep + ((t) >= tsplit ? segd : 0))
#define PG8_SA(b, h) (((b) * 2 + (h)) * HTB)
#define PG8_SB(b, h) ((4 + (b) * 2 + (h)) * HTB)
#define PG8_STAGE(bufoff, gbase, voff) do { _Pragma("unroll") for (int _i = 0; _i < 2; ++_i) \
    __builtin_amdgcn_global_load_lds((const unsigned*)((const char*)(gbase) + (voff)[_i]), (LAS unsigned*)(lds + (bufoff) + ldsw + _i * 8192), 16, 0, 0); } while (0)
#define PG8_LDA(dst, b, h) do { _Pragma("unroll") for (int m = 0; m < 4; ++m) _Pragma("unroll") for (int k = 0; k < 2; ++k) dst[m][k] = *(const LAS bf16x8*)(lds + PG8_SA(b, h) + aoff + m * 2048 + k * 1024); } while (0)
#define PG8_LDB(dst, b, h) do { _Pragma("unroll") for (int n = 0; n < 2; ++n) _Pragma("unroll") for (int k = 0; k < 2; ++k) dst[n][k] = *(const LAS bf16x8*)(lds + PG8_SB(b, h) + boff + n * 2048 + k * 1024); } while (0)
#define PG8_MMA(ai, bj, At, Bt) do { __builtin_amdgcn_s_setprio(1); _Pragma("unroll") for (int m = 0; m < 4; ++m) _Pragma("unroll") for (int n = 0; n < 2; ++n) _Pragma("unroll") for (int k = 0; k < 2; ++k) \
    acc[ai][bj][m][n] = __builtin_amdgcn_mfma_f32_16x16x32_bf16(Bt[n][k], At[m][k], acc[ai][bj][m][n], 0, 0, 0); __builtin_amdgcn_s_setprio(0); } while (0)
#define PG8_WAIT_V(n) asm volatile("s_waitcnt vmcnt(" #n ")" ::: "memory")
#define PG8_WAIT_L(n) asm volatile("s_waitcnt lgkmcnt(" #n ")" ::: "memory")
#define PG8_BAR __builtin_amdgcn_s_barrier()
#define PG8_SCHED __builtin_amdgcn_sched_barrier(0)
  Unit cur, nxt; int ui = 0;
  if (!S.next(0, cur)) return;
  f32x4 acc[2][2][4][2];
#pragma unroll
  for (int a = 0; a < 2; ++a)
#pragma unroll
    for (int b = 0; b < 2; ++b)
#pragma unroll
      for (int m = 0; m < 4; ++m)
#pragma unroll
        for (int n = 0; n < 2; ++n) acc[a][b][m][n] = (f32x4){0.f, 0.f, 0.f, 0.f};
  bf16x8 At[4][2], B0[2][2], B1[2][2];
  const char* cA = (const char*)g.A + (size_t)cur.pm * tstepA; const char* cB = (const char*)g.Bt + (size_t)cur.pn * tstepB;
  PG8_STAGE(PG8_SB(0, 0), cB, voffB); PG8_STAGE(PG8_SA(0, 0), cA, voffA); PG8_STAGE(PG8_SB(0, 1), cB + hstepB, voffB); PG8_STAGE(PG8_SA(0, 1), cA + hstepA, voffA);
  if (wr == 1) PG8_BAR;
  PG8_WAIT_V(4); PG8_BAR;
  PG8_STAGE(PG8_SB(1, 0), cB + kstep, voffB); PG8_STAGE(PG8_SA(1, 0), cA + kstep, voffA); PG8_STAGE(PG8_SB(1, 1), cB + hstepB + kstep, voffB);
  PG8_WAIT_V(6); PG8_BAR;
  for (;;) {
    const bool has_next = S.next(ui + 1, nxt);
    const char* nA = has_next ? (const char*)g.A + (size_t)nxt.pm * tstepA : cA; const char* nB = has_next ? (const char*)g.Bt + (size_t)nxt.pn * tstepB : cB;
    for (int t = 0; t < nt; t += 2) {
      const bool last = (t == nt - 2);
      const char* a1 = cA + PG8_AK(t + 1);
      const char* a2 = last ? nA : cA + PG8_AK(t + 2); const char* b2 = last ? nB : cB + (size_t)(t + 2) * kstep;
      const char* a3 = a2 + kstep; const char* b3 = b2 + kstep;
      PG8_LDB(B0, 0, 0); PG8_SCHED; PG8_LDA(At, 0, 0); PG8_STAGE(PG8_SA(1, 1), a1 + hstepA, voffA);
      PG8_WAIT_L(8); PG8_BAR; PG8_WAIT_L(0); PG8_MMA(0, 0, At, B0); PG8_BAR; PG8_SCHED;
      PG8_LDB(B1, 0, 1); PG8_STAGE(PG8_SB(0, 0), b2, voffB);
      PG8_BAR; PG8_WAIT_L(0); PG8_MMA(0, 1, At, B1); PG8_BAR;
      PG8_LDA(At, 0, 1); PG8_STAGE(PG8_SA(0, 0), a2, voffA);
      PG8_BAR; PG8_WAIT_L(0); PG8_MMA(1, 0, At, B0); PG8_BAR; PG8_SCHED;
      PG8_STAGE(PG8_SB(0, 1), b2 + hstepB, voffB);
      PG8_WAIT_V(6); PG8_BAR; PG8_MMA(1, 1, At, B1); PG8_BAR;
      PG8_LDB(B0, 1, 0); PG8_SCHED; PG8_LDA(At, 1, 0); PG8_STAGE(PG8_SA(0, 1), a2 + hstepA, voffA);
      PG8_WAIT_L(8); PG8_BAR; PG8_WAIT_L(0); PG8_MMA(0, 0, At, B0); PG8_BAR; PG8_SCHED;
      PG8_LDB(B1, 1, 1); PG8_STAGE(PG8_SB(1, 0), b3, voffB);
      PG8_BAR; PG8_WAIT_L(0); PG8_MMA(0, 1, At, B1); PG8_BAR;
      PG8_LDA(At, 1, 1); PG8_STAGE(PG8_SA(1, 0), a3, voffA);
      PG8_BAR; PG8_WAIT_L(0); PG8_MMA(1, 0, At, B0); PG8_BAR; PG8_SCHED;
      PG8_STAGE(PG8_SB(1, 1), b3 + hstepB, voffB);
      PG8_WAIT_V(6); PG8_BAR; PG8_MMA(1, 1, At, B1); PG8_BAR;
    }
    E(acc, cur, wr, wc, fr, fq);
    if (!has_next) break;
#pragma unroll
    for (int a = 0; a < 2; ++a)
#pragma unroll
      for (int b = 0; b < 2; ++b)
#pragma unroll
        for (int m = 0; m < 4; ++m)
#pragma unroll
          for (int n = 0; n < 2; ++n) acc[a][b][m][n] = (f32x4){0.f, 0.f, 0.f, 0.f};
    cur = nxt; cA = nA; cB = nB; ++ui;
  }
  PG8_WAIT_V(0);
  if (wr == 0) PG8_BAR;
  PG8_BAR;
#undef PG8_AK
#undef PG8_SA
#undef PG8_SB
#undef PG8_STAGE
#undef PG8_LDA
#undef PG8_LDB
#undef PG8_MMA
#undef PG8_WAIT_V
#undef PG8_WAIT_L
#undef PG8_BAR
#undef PG8_SCHED
}
}

enum { EP_IN = 0, EP_Q = 1, EP_KV = 2, EP_MIX = 3, EP_UP = 4, EP_DOWN = 5 };
template <int MODE> struct Epi {
  char* ws; char* dout; int rowbase;
  DI void operator()(const f32x4 (&acc)[2][2][4][2], const pg8::Unit& u, int wr, int wc, int fr, int fq) const {
    const int pn = u.pn;
    const int cl = wc * 32 + 8 * fq;
#pragma unroll
    for (int ai = 0; ai < 2; ++ai)
#pragma unroll
      for (int m = 0; m < 4; ++m) {
        const int row = u.pm * 256 + ai * 128 + wr * 64 + m * 16 + fr;
        const int grow = rowbase + row;
        float rs = 1.f;
        if (MODE == EP_IN) rs = ((const float*)(ws + OFF_RS0))[grow];
        if (MODE == EP_UP) rs = ((const float*)(ws + OFF_RS2))[grow];
        if (MODE == EP_Q || MODE == EP_KV) {
          const f32x4* sp = (const f32x4*)(ws + OFF_SSQA) + (size_t)grow * 4 + (MODE == EP_KV ? 2 : 0);
          const f32x4 s0 = sp[0], s1 = sp[1];
          const float ss = (s0[0] + s0[1]) + (s0[2] + s0[3]) + (s1[0] + s1[1]) + (s1[2] + s1[3]);
          rs = __builtin_amdgcn_rsqf(ss * (1.0f / 512) + EPS);
          if (MODE == EP_Q) rs *= QSCALE;
        }
        float ssq = 0.f;
#pragma unroll
        for (int bj = 0; bj < 2; ++bj) {
          f32x4 v0 = acc[ai][bj][m][0] * rs, v1 = acc[ai][bj][m][1] * rs;
          if (MODE == EP_IN || MODE == EP_MIX || MODE == EP_DOWN) {
#pragma unroll
            for (int j = 0; j < 4; ++j) ssq += v0[j] * v0[j] + v1[j] * v1[j];
          }
          if (MODE == EP_UP) {
#pragma unroll
            for (int j = 0; j < 4; ++j) { float a = fmaxf(v0[j], 0.f), b = fmaxf(v1[j], 0.f); v0[j] = a * a; v1[j] = b * b; }
          }
          bf16_t* dst;
          const int ct = bj * 128 + cl;
          if (MODE == EP_IN) {
            if (pn < 4) dst = (bf16_t*)(ws + OFF_PROJA) + (size_t)grow * 1024 + pn * 256 + ct;
            else if (pn < 16) dst = (bf16_t*)(ws + OFF_PROJG) + (size_t)grow * 3072 + (pn - 4) * 256 + ct;
            else dst = (bf16_t*)(ws + OFF_PROJS) + (size_t)grow * 256 + ct;
          } else if (MODE == EP_Q) {
            if (pn < 4) dst = (bf16_t*)(dout + DO_Q) + (size_t)grow * 1536 + (pn * 2 + bj) * 192 + cl;
            else {
              const int mm = (pn - 4) * 256 + ct, h = mm >> 6, r = mm & 63;
              dst = (bf16_t*)(dout + DO_Q) + (size_t)grow * 1536 + h * 192 + 128 + r;
              const int pos = grow < TP ? (grow & 4095) : grow - TP;
              const f32x4* tb = (const f32x4*)((const f32x2*)(ws + OFF_ROPE) + pos * 32 + (r >> 1));
              const f32x4 t0 = tb[0], t1 = tb[1];
              f32x4 o0, o1;
              o0[0] = v0[0] * t0[0] - v0[1] * t0[1]; o0[1] = v0[1] * t0[0] + v0[0] * t0[1];
              o0[2] = v0[2] * t0[2] - v0[3] * t0[3]; o0[3] = v0[3] * t0[2] + v0[2] * t0[3];
              o1[0] = v1[0] * t1[0] - v1[1] * t1[1]; o1[1] = v1[1] * t1[0] + v1[0] * t1[1];
              o1[2] = v1[2] * t1[2] - v1[3] * t1[3]; o1[3] = v1[3] * t1[2] + v1[2] * t1[3];
              v0 = o0; v1 = o1;
            }
          } else if (MODE == EP_KV) {
            dst = (bf16_t*)(ws + OFF_XB) + (size_t)grow * 2048 + pn * 256 + ct;
          } else if (MODE == EP_MIX) {
            dst = (bf16_t*)(ws + OFF_MIX) + (size_t)grow * 2048 + pn * 256 + ct;
          } else if (MODE == EP_UP) {
            dst = (bf16_t*)(ws + OFF_U) + (size_t)row * 8192 + pn * 256 + ct;
          } else {
            dst = (bf16_t*)dout + (size_t)grow * 4096 + pn * 256 + ct;
          }
          u32x4 w = {pk2(v0[0], v0[1]), pk2(v0[2], v0[3]), pk2(v1[0], v1[1]), pk2(v1[2], v1[3])};
          *(u32x4*)dst = w;
        }
        if (MODE == EP_IN || MODE == EP_MIX || MODE == EP_DOWN) {
          ssq += __shfl_xor(ssq, 16); ssq += __shfl_xor(ssq, 32);
          if (fq == 0) {
            if (MODE == EP_IN) { if (pn < 4) ((float*)(ws + OFF_SSQA))[(size_t)grow * 16 + pn * 4 + wc] = ssq; }
            else ((float*)(ws + OFF_SSQM))[(size_t)grow * 32 + pn * 4 + wc] = ssq;
          }
        }
      }
  }
};

template <int MODE>
DI void run_gemm(const Params& p, char* lds, const bf16_t* A, int lda, const bf16_t* Bt, int M, int N, int K, int rowbase, long segd = 0, int tsplit = 1 << 30) {
  pg8::Gemm g; g.A = A; g.Bt = Bt; g.M = M; g.N = N; g.K = K; g.lda = lda; g.segd = segd; g.tsplit = tsplit;
  pg8::StaticOrder S; S.init(M, N, gridDim.x, blockIdx.x, MODE == EP_UP ? 4 : pg8::WGM);
  Epi<MODE> E; E.ws = p.ws; E.dout = p.out; E.rowbase = rowbase;
  pg8::gemm_phase((LAS unsigned char*)lds, g, S, E);
}

constexpr int A_SHM_V = 64 * 128 * 2, A_SHM_K = 64 * 128 * 2, A_SHM_P = 64 * 64 * 2;
#define KSWZ(row, colB) ((row) * 256 + ((colB) ^ (((row) & 15) << 4)))
#define PSWZ(row, colB) ((row) * 128 + ((colB) ^ ((((row) >> 1) & 7) << 4)))
#define SBAR() __builtin_amdgcn_sched_barrier(0)
constexpr float ATH = 11.5f;
DI void a_partialSM(f32x16& p0, f32x16& p1, float& m_reg, float& mn, float& alpha) {
  float pmax = p0[0];
#pragma unroll
  for (int r = 1; r < 16; ++r) pmax = fmaxf(pmax, p0[r]);
#pragma unroll
  for (int r = 0; r < 16; ++r) pmax = fmaxf(pmax, p1[r]);
  { auto rr = __builtin_amdgcn_permlane32_swap(__float_as_uint(pmax), __float_as_uint(pmax), false, false);
    pmax = fmaxf(__uint_as_float(rr[0]), __uint_as_float(rr[1])); }
  if (__builtin_expect(__all(pmax - m_reg <= ATH), 1)) { mn = m_reg; alpha = 1.f; }
  else { mn = fmaxf(m_reg, pmax); alpha = __builtin_amdgcn_exp2f(m_reg - mn); m_reg = mn; }
#pragma unroll
  for (int r = 0; r < 16; ++r) p0[r] = p0[r] - mn;
#pragma unroll
  for (int r = 0; r < 16; ++r) p1[r] = p1[r] - mn;
#pragma unroll
  for (int r = 0; r < 16; ++r) p0[r] = __builtin_amdgcn_exp2f(p0[r]);
}
DI void a_finishSM(f32x16& p0, f32x16& p1, float alpha, float& l_reg, bf16x8& pa0, bf16x8& pa1, bf16x8& pa2, bf16x8& pa3) {
#pragma unroll
  for (int r = 0; r < 16; ++r) p1[r] = __builtin_amdgcn_exp2f(p1[r]);
  float ps = 0;
#pragma unroll
  for (int r = 0; r < 16; ++r) ps += p0[r];
#pragma unroll
  for (int r = 0; r < 16; ++r) ps += p1[r];
  { auto rr = __builtin_amdgcn_permlane32_swap(__float_as_uint(ps), __float_as_uint(ps), false, false);
    ps = __uint_as_float(rr[0]) + __uint_as_float(rr[1]); }
  l_reg = l_reg * alpha + ps;
#define PK4(P, BASE, OUT) do { unsigned a0 = pk2(P[BASE + 0], P[BASE + 1]), a1 = pk2(P[BASE + 2], P[BASE + 3]);   \
    unsigned b0 = pk2(P[BASE + 4], P[BASE + 5]), b1 = pk2(P[BASE + 6], P[BASE + 7]);                              \
    auto r0 = __builtin_amdgcn_permlane32_swap(a0, b0, false, false); auto r1 = __builtin_amdgcn_permlane32_swap(a1, b1, false, false); \
    u32x4 w = {r0[0], r1[0], r0[1], r1[1]}; OUT = __builtin_bit_cast(bf16x8, w); } while (0)
  PK4(p0, 0, pa0); PK4(p0, 8, pa1); PK4(p1, 0, pa2); PK4(p1, 8, pa3);
#undef PK4
}
DI void a_qkt(f32x16& p0, f32x16& p1, const char* Ks, const char* Ps, const bf16x8* qr, const char* QP, int r32, int hi) {
  p0 = f32x16{}; p1 = f32x16{};
#pragma unroll
  for (int d0 = 0; d0 < 8; ++d0) { const int cb = (d0 * 16 + hi * 8) * 2;
    bf16x8 b0 = *reinterpret_cast<const bf16x8*>(Ks + KSWZ(r32, cb));
    bf16x8 b1 = *reinterpret_cast<const bf16x8*>(Ks + KSWZ(32 + r32, cb));
    p0 = MFMA32(b0, qr[d0], p0);
    p1 = MFMA32(b1, qr[d0], p1); }
#pragma unroll
  for (int d0 = 0; d0 < 4; ++d0) { const int cb = (d0 * 16 + hi * 8) * 2;
    bf16x8 b0 = *reinterpret_cast<const bf16x8*>(Ps + PSWZ(r32, cb));
    bf16x8 b1 = *reinterpret_cast<const bf16x8*>(Ps + PSWZ(32 + r32, cb));
    const bf16x8 qp = *reinterpret_cast<const bf16x8*>(QP + d0 * 1024);
    p0 = MFMA32(b0, qp, p0);
    p1 = MFMA32(b1, qp, p1); }
}
DI int v_st(int k, int c) { const int kk = (k & ~0xC) | ((k & 4) << 1) | ((k & 8) >> 1); return ((kk >> 3) * 4 + (c >> 5)) * 512 + ((kk & 7) * 32 + (c & 31)) * 2; }
DI int v_rd_base(int lane) { return ((lane & 3) << 3) | (((lane >> 2) & 3) << 6) | (((lane >> 4) & 1) << 5) | (((lane >> 5) & 1) << 8); }
constexpr int v_rd_off(int d0, int ks, int half) { return d0 * 512 + ks * 4096 + half * 2048; }
template <int OFF> DI s16x4 tr_read(int vb) {
  s16x4 r; asm volatile("ds_read_b64_tr_b16 %0, %1 offset:%2" : "=&v"(r) : "v"(vb), "i"(OFF) : "memory"); return r;
}
template <int D0> DI void pv_one(f32x16& od, int vb, bf16x8 pa0, bf16x8 pa1, bf16x8 pa2, bf16x8 pa3) {
  const s16x4 l0 = tr_read<v_rd_off(D0, 0, 0)>(vb), h0 = tr_read<v_rd_off(D0, 0, 1)>(vb), l1 = tr_read<v_rd_off(D0, 1, 0)>(vb), h1 = tr_read<v_rd_off(D0, 1, 1)>(vb);
  const s16x4 l2 = tr_read<v_rd_off(D0, 2, 0)>(vb), h2 = tr_read<v_rd_off(D0, 2, 1)>(vb), l3 = tr_read<v_rd_off(D0, 3, 0)>(vb), h3 = tr_read<v_rd_off(D0, 3, 1)>(vb);
  asm volatile("s_waitcnt lgkmcnt(0)" ::: "memory"); SBAR();
#define PKV(L, H) (bf16x8){L[0], L[1], L[2], L[3], H[0], H[1], H[2], H[3]}
  od = MFMA32(pa0, PKV(l0, h0), od);
  od = MFMA32(pa1, PKV(l1, h1), od);
  od = MFMA32(pa2, PKV(l2, h2), od);
  od = MFMA32(pa3, PKV(l3, h3), od);
#undef PKV
}
DI void pv_d0(f32x16* o, int vb, bf16x8 pa0, bf16x8 pa1, bf16x8 pa2, bf16x8 pa3) {
  pv_one<0>(o[0], vb, pa0, pa1, pa2, pa3); pv_one<1>(o[1], vb, pa0, pa1, pa2, pa3); pv_one<2>(o[2], vb, pa0, pa1, pa2, pa3); pv_one<3>(o[3], vb, pa0, pa1, pa2, pa3);
}

#define PV_BLOCK(D0) { \
    const s16x4 l0 = tr_read<v_rd_off(D0, 0, 0)>(vb), h0 = tr_read<v_rd_off(D0, 0, 1)>(vb), l1 = tr_read<v_rd_off(D0, 1, 0)>(vb), h1 = tr_read<v_rd_off(D0, 1, 1)>(vb); \
    const s16x4 l2 = tr_read<v_rd_off(D0, 2, 0)>(vb), h2 = tr_read<v_rd_off(D0, 2, 1)>(vb), l3 = tr_read<v_rd_off(D0, 3, 0)>(vb), h3 = tr_read<v_rd_off(D0, 3, 1)>(vb); \
    asm volatile("s_waitcnt lgkmcnt(0)" ::: "memory"); SBAR(); \
    o[D0] = MFMA32(pa0, ((bf16x8){l0[0], l0[1], l0[2], l0[3], h0[0], h0[1], h0[2], h0[3]}), o[D0]); \
    o[D0] = MFMA32(pa1, ((bf16x8){l1[0], l1[1], l1[2], l1[3], h1[0], h1[1], h1[2], h1[3]}), o[D0]); \
    o[D0] = MFMA32(pa2, ((bf16x8){l2[0], l2[1], l2[2], l2[3], h2[0], h2[1], h2[2], h2[3]}), o[D0]); \
    o[D0] = MFMA32(pa3, ((bf16x8){l3[0], l3[1], l3[2], l3[3], h3[0], h3[1], h3[2], h3[3]}), o[D0]); }
DI void pv_sm(f32x16* o, int vb, bf16x8 pa0, bf16x8 pa1, bf16x8 pa2, bf16x8 pa3, f32x16& p0, f32x16& p1, float& m_reg, float& mn, float& alpha) {
  PV_BLOCK(0)
  float pm0 = p0[0];
#pragma unroll
  for (int r = 1; r < 16; ++r) pm0 = fmaxf(pm0, p0[r]);
  PV_BLOCK(1)
  float pmax = pm0;
#pragma unroll
  for (int r = 0; r < 16; ++r) pmax = fmaxf(pmax, p1[r]);
  { auto rr = __builtin_amdgcn_permlane32_swap(__float_as_uint(pmax), __float_as_uint(pmax), false, false);
    pmax = fmaxf(__uint_as_float(rr[0]), __uint_as_float(rr[1])); }
  const bool keep = __all(pmax - m_reg <= ATH);
  mn = keep ? m_reg : fmaxf(m_reg, pmax);
  alpha = __builtin_amdgcn_exp2f(m_reg - mn);
  m_reg = mn;
  PV_BLOCK(2)
#pragma unroll
  for (int r = 0; r < 16; ++r) { p0[r] = p0[r] - mn; p1[r] = p1[r] - mn; }
  PV_BLOCK(3)
#pragma unroll
  for (int r = 0; r < 16; ++r) p0[r] = __builtin_amdgcn_exp2f(p0[r]);
}

DI void attn_unit(const bf16_t* __restrict__ Qb, const bf16_t* __restrict__ Kh, const bf16_t* __restrict__ Vh, const bf16_t* __restrict__ Ph,
                  bf16_t* __restrict__ Ob, int seq, float* __restrict__ lse_out, char* lds) {
  constexpr int LDQ = 1536, LDK = 2048, LDP = 64, LDO = 1024;
  int tid = threadIdx.x; asm volatile("" : "+v"(tid));
  const int wid = tid >> 6, lane = tid & 63, r32 = lane & 31, hi = lane >> 5;
  constexpr int A_STG = 40960, A_KO = 16384, A_PO = 32768;
  float* wsf = (float*)(lds + 155648) + wid * 64; float* li_l = wsf; float* al_l = wsf + 32;
  float m_reg = -1e30f, l_reg = 0; f32x16 o[4] = {}; bf16x8 qr[8];
  char* QP = lds + 122880 + wid * 4096 + lane * 16;
  const bf16_t* Qw = Qb + (long)(wid * 32 + r32) * LDQ + hi * 8;
#pragma unroll
  for (int d0 = 0; d0 < 8; ++d0) qr[d0] = *reinterpret_cast<const bf16x8*>(Qw + d0 * 16);
#pragma unroll
  for (int d0 = 0; d0 < 4; ++d0) *reinterpret_cast<bf16x8*>(QP + d0 * 1024) = *reinterpret_cast<const bf16x8*>(Qw + 128 + d0 * 16);
  const int sr = tid >> 4, sc = (tid & 15) * 8, vst0 = v_st(sr, sc), vst1 = v_st(32 + sr, sc);
  const int pr = tid >> 3, pc = (tid & 7) * 8;
  const int vb0 = (int)(unsigned)(size_t)(LAS char*)lds + v_rd_base(lane);
  bf16x8 vs0, vs1, ks0, ks1, ps0;
#define SLOAD(k0) do { vs0 = *(const bf16x8*)(&Vh[(long)((k0) + sr) * LDK + sc]); vs1 = *(const bf16x8*)(&Vh[(long)((k0) + 32 + sr) * LDK + sc]); \
    ks0 = *(const bf16x8*)(&Kh[(long)((k0) + sr) * LDK + sc]); ks1 = *(const bf16x8*)(&Kh[(long)((k0) + 32 + sr) * LDK + sc]); \
    ps0 = *(const bf16x8*)(&Ph[(long)((k0) + pr) * LDP + pc]); } while (0)
#define SWRITE(st) do { char* b_ = lds + (st); *(bf16x8*)(b_ + vst0) = vs0; *(bf16x8*)(b_ + vst1) = vs1; const int kc = sc * 2; \
    *(bf16x8*)(b_ + A_KO + KSWZ(sr, kc)) = ks0; *(bf16x8*)(b_ + A_KO + KSWZ(32 + sr, kc)) = ks1; \
    *(bf16x8*)(b_ + A_PO + PSWZ(pr, pc * 2)) = ps0; } while (0)
#define SWAIT() asm volatile("s_waitcnt vmcnt(0)" ::: "memory")
#define RESC(a) do { if (__any((a) < 1.f)) { if (hi == 0) al_l[r32] = (a); asm volatile("s_waitcnt lgkmcnt(0)" ::: "memory"); \
    _Pragma("unroll") for (int d = 0; d < 4; ++d) _Pragma("unroll") for (int r = 0; r < 16; ++r) o[d][r] *= al_l[crow(r, hi)]; } } while (0)
  f32x16 pA0, pA1, pB0, pB1; float mnA, mnB, alA, alB; bf16x8 pa0, pa1, pa2, pa3; const int NT = seq / 64;
  SLOAD(0); SWAIT(); SWRITE(0); __syncthreads();
  a_qkt(pA0, pA1, lds + A_KO, lds + A_PO, qr, QP, r32, hi); a_partialSM(pA0, pA1, m_reg, mnA, alA);
  SLOAD(64);
  SWAIT(); SWRITE(A_STG); __syncthreads();
  int sV = 0, sK = A_STG, sW = 2 * A_STG;
  for (int j = 1; j + 1 < NT; j += 2) {
    SBAR(); a_qkt(pB0, pB1, lds + sK + A_KO, lds + sK + A_PO, qr, QP, r32, hi);
    a_finishSM(pA0, pA1, alA, l_reg, pa0, pa1, pa2, pa3); SBAR();
    SLOAD((j + 1) * 64); SBAR();
    pv_sm(o, vb0 + sV, pa0, pa1, pa2, pa3, pB0, pB1, m_reg, mnB, alB);
    SWAIT(); SWRITE(sW);
    RESC(alB); __syncthreads();
    { const int t_ = sV; sV = sK; sK = sW; sW = t_; }
    SBAR(); a_qkt(pA0, pA1, lds + sK + A_KO, lds + sK + A_PO, qr, QP, r32, hi);
    a_finishSM(pB0, pB1, alB, l_reg, pa0, pa1, pa2, pa3); SBAR();
    SLOAD((j + 2) * 64); SBAR();
    pv_sm(o, vb0 + sV, pa0, pa1, pa2, pa3, pA0, pA1, m_reg, mnA, alA);
    SWAIT(); SWRITE(sW);
    RESC(alA); __syncthreads();
    { const int t_ = sV; sV = sK; sK = sW; sW = t_; }
  }
  SBAR(); a_qkt(pB0, pB1, lds + sK + A_KO, lds + sK + A_PO, qr, QP, r32, hi);
  a_finishSM(pA0, pA1, alA, l_reg, pa0, pa1, pa2, pa3); SBAR();
  pv_sm(o, vb0 + sV, pa0, pa1, pa2, pa3, pB0, pB1, m_reg, mnB, alB);
  __syncthreads(); RESC(alB);
  a_finishSM(pB0, pB1, alB, l_reg, pa0, pa1, pa2, pa3); SBAR();
  pv_d0(o, vb0 + sK, pa0, pa1, pa2, pa3);
  if (hi == 0) li_l[r32] = l_reg; asm volatile("s_waitcnt lgkmcnt(0)" ::: "memory");
  if (lse_out != nullptr && hi == 0) lse_out[wid * 32 + r32] = m_reg + __builtin_amdgcn_logf(l_reg);
  float rli[16];
#pragma unroll
  for (int r = 0; r < 16; ++r) rli[r] = __builtin_amdgcn_rcpf(li_l[crow(r, hi)]);
  bf16_t* Ow = Ob + (long)(wid * 32) * LDO;
#pragma unroll
  for (int r = 0; r < 16; ++r) { const int orow = crow(r, hi);
#pragma unroll
    for (int d0 = 0; d0 < 4; ++d0) { const float v = o[d0][r] * rli[r]; Ow[(long)orow * LDO + d0 * 32 + r32] = (bf16_t)(pk2(v, v) & 0xffffu); } }
#undef SLOAD
#undef SWRITE
#undef SWAIT
#undef RESC
}

constexpr int G_QD = 0, G_KI = 17408, G_KT = 34816, G_VT = 53248, G_XS = 90112, G_GF = 99328, G_GT = 103424, G_DEC = 107520, G_WG = 108032, G_WGL = 114176, G_OT = 120320;
constexpr int QDS = 272, KTS = 144;
#define LBAR() do { asm volatile("s_waitcnt lgkmcnt(0)" ::: "memory"); __builtin_amdgcn_s_barrier(); asm volatile("" ::: "memory"); } while (0)
DI float logsig16(float z) { return -(fmaxf(-z, 0.f) + __logf(1.f + __expf(-fabsf(z)))) * (1.0f / 16.0f); }

DI void gla_task(const Params& p, int task, char* lds) {
  int tid = threadIdx.x; asm volatile("" : "+v"(tid));
  const int wid = __builtin_amdgcn_readfirstlane(tid >> 6), lane = tid & 63, r32_ = lane & 31, hi_ = lane >> 5;
  int seqstart, NC, sub, vh = 0; bool split = false;
  if (task < 16) { seqstart = TP; NC = 256; sub = task >> 1; vh = task & 1; split = true; } else { const int t2 = task - 16; seqstart = (t2 >> 3) * 4096; NC = 64; sub = t2 & 7; }
  const int dir = sub & 1, h = sub >> 1;
  const int dvb = split ? 4 * vh + wid : wid;
  const bool act = !split || wid < 4;
  const bf16_t* PG = (const bf16_t*)(p.ws + OFF_PROJG);
  const bf16_t* PS = (const bf16_t*)(p.ws + OFF_PROJS);
  bf16_t* OUT = (bf16_t*)(p.out + (dir ? DO_OB : DO_OF));
  const int chp = tid & 63, g = wid, c0_ = 2 * chp;
  __syncthreads();
  {
    const float* W = dir ? p.w_gk_b : p.w_gk_f;
    for (int i = tid; i < 16 * 128; i += 512) {
      const int kk = i >> 7, ch = i & 127;
      const float w = W[kk * 512 + h * 128 + ch];
      const unsigned hb = pk2(w, w) & 0xffffu;
      const float wl = w - __uint_as_float(hb << 16);
      *(short*)(lds + G_WG + ch * 48 + kk * 2) = (short)hb;
      *(short*)(lds + G_WGL + ch * 48 + kk * 2) = (short)(pk2(wl, wl) & 0xffffu);
    }
    if (tid < 64) {
      const int l15 = tid & 15, q4 = tid >> 4;
      *(u32x2*)(lds + G_XS + l15 * KTS + (16 + 4 * q4) * 2) = (u32x2){0u, 0u};
      *(u32x2*)(lds + G_XS + (32 + l15) * KTS + (48 + 4 * q4) * 2) = (u32x2){0u, 0u};
    }
  }
  const float biasm = ((dir ? p.b_gk_b : p.b_gk_f) + h * 128)[32 * (wid & 3) + r32_];
  f32x16 S[4] = {};
  const int spos_ = tid >> 3, sc8_ = (tid & 7) * 8;
  const int vsr_ = tid >> 4, vsc_ = (tid & 15) * 8;
  bf16x8 rq0, rq1, rk0, rk1, rv0, rv1, rv2, rv3, rg;
  rg = bf16x8{}; rv0 = bf16x8{}; rv1 = bf16x8{}; rv2 = bf16x8{}; rv3 = bf16x8{};
#define GLOAD(n) do { const int c_ = dir ? NC - 1 - (n) : (n); const long tok_ = (long)seqstart + c_ * 64 + (dir ? 63 - spos : spos); \
    const bf16_t* rp_ = PG + tok_ * 3072; \
    rq0 = *(const bf16x8*)(rp_ + h * 128 + sc8); rq1 = *(const bf16x8*)(rp_ + h * 128 + 64 + sc8); \
    rk0 = *(const bf16x8*)(rp_ + 512 + h * 128 + sc8); rk1 = *(const bf16x8*)(rp_ + 512 + h * 128 + 64 + sc8); \
    { const long tv0_ = (long)seqstart + c_ * 64 + (dir ? 63 - vsr : vsr), tv1_ = (long)seqstart + c_ * 64 + (dir ? 31 - vsr : 32 + vsr); \
      const bf16_t* v0_ = PG + tv0_ * 3072 + 1024 + h * 256 + vsc; const bf16_t* v1_ = PG + tv1_ * 3072 + 1024 + h * 256 + vsc; \
      if (!split || vh == 0) { rv0 = *(const bf16x8*)(v0_); rv1 = *(const bf16x8*)(v1_); } if (!split || vh == 1) { rv2 = *(const bf16x8*)(v0_ + 128); rv3 = *(const bf16x8*)(v1_ + 128); } } \
    if (tid < 128) { const long tg_ = (long)seqstart + c_ * 64 + (dir ? 63 - (tid >> 1) : (tid >> 1)); rg = *(const bf16x8*)(PS + tg_ * 256 + 64 + dir * 16 + (tid & 1) * 8); } } while (0)
#define GFL_READ() do { const int ch_ = lane_v & 3, p0_ = lane_v >> 2; \
    _Pragma("unroll") for (int e_ = 0; e_ < 4; ++e_) ow[e_] = *(const u32x4*)(lds + G_OT + wid * 4096 + (p0_ + 16 * e_) * 64 + ch_ * 16); } while (0)
#define GFL_STORE(np) do { const int c_ = dir ? NC - 1 - (np) : (np); const long tb_ = (long)seqstart + c_ * 64; \
    const int ch_ = lane_v & 3, p0_ = lane_v >> 2; \
    _Pragma("unroll") for (int e_ = 0; e_ < 4; ++e_) { const int pos_ = p0_ + 16 * e_; \
      const long t_ = tb_ + (dir ? 63 - pos_ : pos_); \
      *(u32x4*)(OUT + t_ * 1024 + h * 256 + 32 * dvb + ch_ * 8) = ow[e_]; } } while (0)
  u32x4 ow[4] = {};
  { const int spos = spos_, sc8 = sc8_, vsr = vsr_, vsc = vsc_; GLOAD(0); }
  for (int n = 0; n < NC; ++n) {
    int tidv = tid; asm volatile("" : "+v"(tidv));
    const int lanev = tidv & 63, r32 = lanev & 31, hi = lanev >> 5, c0 = 2 * lanev, spos = tidv >> 3, sc8 = (tidv & 7) * 8, vsr = tidv >> 4, vsc = (tidv & 15) * 8;
    if (tid < 128) *(bf16x8*)(lds + G_GF + (tid >> 1) * 48 + (tid & 1) * 16) = rg;
    { const int lane_v = r32 | (hi << 5); if (n > 0 && act) GFL_READ(); }
    LBAR();
    {
      const int tm = wid >> 2, tn = wid & 3;
      const bf16x8 ga = *(const bf16x8*)(lds + G_GF + (32 * tm + r32) * 48 + hi * 16);
      const bf16x8 bh = *(const bf16x8*)(lds + G_WG + (32 * tn + r32) * 48 + hi * 16);
      const bf16x8 bl = *(const bf16x8*)(lds + G_WGL + (32 * tn + r32) * 48 + hi * 16);
      f32x16 z = {};
      z = MFMA32(ga, bh, z); z = MFMA32(ga, bl, z);
      float* zl = (float*)(lds + G_OT) + (32 * tm + 4 * hi) * 128 + 32 * tn + r32;
#pragma unroll
      for (int r = 0; r < 16; ++r) {
        const float zz = z[r] + biasm;
        const float e = __builtin_amdgcn_exp2f(fabsf(zz) * -1.4426950408889634f);
        const float l = __builtin_amdgcn_logf(1.f + e);
        zl[((r & 3) + 8 * (r >> 2)) * 128] = (fminf(zz, 0.f) * 1.4426950408889634f - l) * 0.0625f;
      }
    }
    LBAR();
    *(bf16x8*)(lds + G_QD + spos * QDS + sc8 * 2) = rq0; *(bf16x8*)(lds + G_QD + spos * QDS + (sc8 + 64) * 2) = rq1;
    *(bf16x8*)(lds + G_KI + spos * QDS + sc8 * 2) = rk0; *(bf16x8*)(lds + G_KI + spos * QDS + (sc8 + 64) * 2) = rk1;
    *(bf16x8*)(lds + G_VT + v_st(vsr, vsc)) = rv0; *(bf16x8*)(lds + G_VT + v_st(32 + vsr, vsc)) = rv1;
    *(bf16x8*)(lds + G_VT + 16384 + v_st(vsr, vsc)) = rv2; *(bf16x8*)(lds + G_VT + 16384 + v_st(32 + vsr, vsc)) = rv3;
    { const int lane_v = r32 | (hi << 5); if (n > 0 && act) GFL_STORE(n - 1); }
    if (n + 1 < NC) GLOAD(n + 1);
    float bl0[8], bl1[8];
    {
      float run0 = 0.f, run1 = 0.f;
#pragma unroll
      for (int r = 0; r < 8; ++r) {
        const f32x2 t = *(const f32x2*)((const float*)(lds + G_OT) + (8 * g + r) * 128 + c0);
        run0 += t[0]; run1 += t[1]; bl0[r] = run0; bl1[r] = run1;
      }
      *(f32x2*)((float*)(lds + G_GT) + g * 128 + c0) = (f32x2){run0, run1};
    }
    LBAR();
    {
      float pre0 = 0.f, pre1 = 0.f, all0 = 0.f, all1 = 0.f;
#pragma unroll
      for (int gg = 0; gg < 8; ++gg) { const f32x2 t = *(const f32x2*)((const float*)(lds + G_GT) + gg * 128 + c0);
        all0 += t[0]; all1 += t[1]; if (gg < g) { pre0 += t[0]; pre1 += t[1]; } }
      const float ea0 = __builtin_amdgcn_exp2f(all0), ea1 = __builtin_amdgcn_exp2f(all1);
      float kt0[8], kt1[8];
#pragma unroll
      for (int r = 0; r < 8; ++r) {
        const float e0 = __builtin_amdgcn_exp2f(pre0 + bl0[r]), e1 = __builtin_amdgcn_exp2f(pre1 + bl1[r]);
        const float i0 = __builtin_amdgcn_rcpf(e0), i1 = __builtin_amdgcn_rcpf(e1);
        unsigned* qp = (unsigned*)(lds + G_QD + (8 * g + r) * QDS + c0 * 2);
        unsigned* kp = (unsigned*)(lds + G_KI + (8 * g + r) * QDS + c0 * 2);
        const unsigned qw = *qp, kw = *kp;
        const float k0 = bflo(kw) * i0, k1 = bfhi(kw) * i1;
        *qp = pk2(bflo(qw) * GLA_QS * e0, bfhi(qw) * GLA_QS * e1);
        *kp = pk2(k0, k1);
        kt0[r] = k0 * ea0; kt1[r] = k1 * ea1;
      }
      u32x4 w0 = {pk2(kt0[0], kt0[1]), pk2(kt0[2], kt0[3]), pk2(kt0[4], kt0[5]), pk2(kt0[6], kt0[7])};
      u32x4 w1 = {pk2(kt1[0], kt1[1]), pk2(kt1[2], kt1[3]), pk2(kt1[4], kt1[5]), pk2(kt1[6], kt1[7])};
      *(u32x4*)(lds + G_KT + c0 * KTS + g * 16) = w0;
      *(u32x4*)(lds + G_KT + (c0 + 1) * KTS + g * 16) = w1;
      if (g == 0) *(f32x2*)((float*)(lds + G_DEC) + c0) = (f32x2){ea0, ea1};
    }
    LBAR();
    {
      const int l15 = lane & 15, q4 = lane >> 4;
#pragma unroll
      for (int rep = 0; rep < 2; ++rep) {
        const int idx = wid + 8 * rep;
        if (idx < 10) {
          int a, bb;
          if (idx < 4) { a = idx; bb = idx; } else if (idx < 7) { a = 0; bb = idx - 3; } else if (idx < 9) { a = 1; bb = idx - 5; } else { a = 2; bb = 3; }
          const char* kb = lds + G_KI + (16 * a + l15) * QDS + q4 * 16;
          const char* qb = lds + G_QD + (16 * bb + l15) * QDS + q4 * 16;
          f32x4 acc = {0.f, 0.f, 0.f, 0.f};
#pragma unroll
          for (int kk = 0; kk < 4; ++kk)
            acc = __builtin_amdgcn_mfma_f32_16x16x32_bf16(*(const bf16x8*)(kb + kk * 64), *(const bf16x8*)(qb + kk * 64), acc, 0, 0, 0);
          if (a == bb) {
#pragma unroll
            for (int r = 0; r < 4; ++r) if (4 * q4 + r > l15) acc[r] = 0.f;
          }
          *(u32x2*)(lds + G_XS + (16 * bb + l15) * KTS + (16 * a + 4 * q4) * 2) = (u32x2){pk2(acc[0], acc[1]), pk2(acc[2], acc[3])};
        }
      }
    }
    LBAR();
    if (act) {
    f32x16 O0 = {}, O1 = {};
    {
      bf16x8 vb[4];
      {
        const int vbase = (int)(unsigned)(size_t)(LAS char*)(lds + G_VT) + (dvb >> 2) * 16384 + (dvb & 3) * 512 + v_rd_base(r32 | (hi << 5));
        const s16x4 l0 = tr_read<v_rd_off(0, 0, 0)>(vbase), h0 = tr_read<v_rd_off(0, 0, 1)>(vbase), l1 = tr_read<v_rd_off(0, 1, 0)>(vbase), h1 = tr_read<v_rd_off(0, 1, 1)>(vbase);
        const s16x4 l2 = tr_read<v_rd_off(0, 2, 0)>(vbase), h2 = tr_read<v_rd_off(0, 2, 1)>(vbase), l3 = tr_read<v_rd_off(0, 3, 0)>(vbase), h3 = tr_read<v_rd_off(0, 3, 1)>(vbase);
        asm volatile("s_waitcnt lgkmcnt(0)" ::: "memory"); SBAR();
        vb[0] = (bf16x8){l0[0], l0[1], l0[2], l0[3], h0[0], h0[1], h0[2], h0[3]};
        vb[1] = (bf16x8){l1[0], l1[1], l1[2], l1[3], h1[0], h1[1], h1[2], h1[3]};
        vb[2] = (bf16x8){l2[0], l2[1], l2[2], l2[3], h2[0], h2[1], h2[2], h2[3]};
        vb[3] = (bf16x8){l3[0], l3[1], l3[2], l3[3], h3[0], h3[1], h3[2], h3[3]};
      }
      const char* xa0 = lds + G_XS + r32 * KTS + hi * 16;
      const char* xa1 = lds + G_XS + (32 + r32) * KTS + hi * 16;
#pragma unroll
      for (int ks = 0; ks < 2; ++ks) O0 = MFMA32(*(const bf16x8*)(xa0 + ks * 32), vb[ks], O0);
#pragma unroll
      for (int ks = 0; ks < 4; ++ks) O1 = MFMA32(*(const bf16x8*)(xa1 + ks * 32), vb[ks], O1);
#pragma unroll
      for (int dkb = 0; dkb < 4; ++dkb) {
#pragma unroll
        for (int s = 0; s < 2; ++s) {
          const bf16x8 xs = pack8(S[dkb], s);
          const char* qa = lds + G_QD + r32 * QDS + (32 * dkb + 16 * s) * 2 + hi * 8;
          {
            const s16x4 lo = *(const s16x4*)(qa), hh = *(const s16x4*)(qa + 16);
            const bf16x8 pa = {lo[0], lo[1], lo[2], lo[3], hh[0], hh[1], hh[2], hh[3]};
            O0 = MFMA32(pa, xs, O0);
          }
          {
            const s16x4 lo = *(const s16x4*)(qa + 32 * QDS), hh = *(const s16x4*)(qa + 32 * QDS + 16);
            const bf16x8 pa = {lo[0], lo[1], lo[2], lo[3], hh[0], hh[1], hh[2], hh[3]};
            O1 = MFMA32(pa, xs, O1);
          }
        }
      }
      const float* dec = (const float*)(lds + G_DEC);
#pragma unroll
      for (int dkb = 0; dkb < 4; ++dkb) {
#pragma unroll
        for (int q4 = 0; q4 < 4; ++q4) {
          const f32x4 d0 = *(const f32x4*)(dec + 32 * dkb + 8 * q4 + 4 * hi);
#pragma unroll
          for (int j = 0; j < 4; ++j) S[dkb][4 * q4 + j] *= d0[j];
        }
        const char* ka = lds + G_KT + (32 * dkb + r32) * KTS + hi * 16;
#pragma unroll
        for (int ks = 0; ks < 4; ++ks) S[dkb] = MFMA32(*(const bf16x8*)(ka + ks * 32), vb[ks], S[dkb]);
      }
    }
    {
      char* ot = lds + G_OT + wid * 4096 + r32 * 2;
#pragma unroll
      for (int r = 0; r < 16; ++r) {
        const int i0 = crow(r, hi);
        *(short*)(ot + i0 * 64) = (short)(pk2(O0[r], O0[r]) & 0xffffu);
        *(short*)(ot + (32 + i0) * 64) = (short)(pk2(O1[r], O1[r]) & 0xffffu);
      }
    }
    }
  }
  if (act) { const int lane_v = lane; GFL_READ(); GFL_STORE(NC - 1); }
#undef GLOAD
#undef GFL_READ
#undef GFL_STORE
}

DI void phase_kpe(const Params& p) {
  const bf16_t* PS = (const bf16_t*)(p.ws + OFF_PROJS);
  unsigned* KPE = (unsigned*)(p.ws + OFF_KPE);
  const f32x2* tab = (const f32x2*)(p.ws + OFF_ROPE);
  for (int idx = blockIdx.x * 512 + threadIdx.x; idx < T * 32; idx += gridDim.x * 512) {
    const int tok = idx >> 5, i = idx & 31;
    const int pos = tok < TP ? (tok & 4095) : tok - TP;
    const float k1 = bf2f((short)PS[(size_t)tok * 256 + i]), k2 = bf2f((short)PS[(size_t)tok * 256 + 32 + i]);
    const f32x2 cs = tab[pos * 32 + i];
    KPE[idx] = pk2(k1 * cs[0] - k2 * cs[1], k2 * cs[0] + k1 * cs[1]);
  }
}
DI void phase_e0(const Params& p) {
  const int tid = threadIdx.x, lane = tid & 63;
  const bf16_t* PG = (const bf16_t*)(p.ws + OFF_PROJG);
  bf16_t* OF = (bf16_t*)(p.out + DO_OF); const bf16_t* OBk = (const bf16_t*)(p.out + DO_OB);
  const int gw = blockIdx.x * 8 + (tid >> 6), nw = gridDim.x * 8;
  float gn[16];
#pragma unroll
  for (int j = 0; j < 16; ++j) gn[j] = p.gla_norm[(lane & 15) * 16 + j];
  for (int row0 = gw; row0 < T; row0 += 4 * nw) {
    u32x4 xa[4][2], ya[4][2], za[4][2];
#pragma unroll
    for (int k = 0; k < 4; ++k) { const size_t row = (size_t)row0 + (size_t)k * nw;
      const u32x4* a = (const u32x4*)(OF + row * 1024 + lane * 16);
      const u32x4* b = (const u32x4*)(OBk + row * 1024 + lane * 16);
      const u32x4* gp = (const u32x4*)(PG + row * 3072 + 2048 + lane * 16);
#pragma unroll
      for (int q = 0; q < 2; ++q) { xa[k][q] = __builtin_nontemporal_load(a + q); ya[k][q] = __builtin_nontemporal_load(b + q); za[k][q] = __builtin_nontemporal_load(gp + q); } }
#pragma unroll
    for (int k = 0; k < 4; ++k) { const size_t row = (size_t)row0 + (size_t)k * nw;
      float v[16], gg[16];
#pragma unroll
      for (int q = 0; q < 2; ++q)
#pragma unroll
        for (int j = 0; j < 4; ++j) { v[q * 8 + 2 * j] = bflo(xa[k][q][j]) + bflo(ya[k][q][j]); v[q * 8 + 2 * j + 1] = bfhi(xa[k][q][j]) + bfhi(ya[k][q][j]);
          gg[q * 8 + 2 * j] = bflo(za[k][q][j]); gg[q * 8 + 2 * j + 1] = bfhi(za[k][q][j]); }
      float ss = 0.f;
#pragma unroll
      for (int j = 0; j < 16; ++j) ss += v[j] * v[j];
      ss += __shfl_xor(ss, 1); ss += __shfl_xor(ss, 2); ss += __shfl_xor(ss, 4); ss += __shfl_xor(ss, 8);
      const float rs = __builtin_amdgcn_rsqf(ss * (1.0f / 256) + EPS);
      float o[16];
#pragma unroll
      for (int j = 0; j < 16; ++j) { const float sg = gg[j] / (1.f + __expf(-gg[j])); o[j] = v[j] * rs * gn[j] * sg; }
      u32x4 w0 = {pk2(o[0], o[1]), pk2(o[2], o[3]), pk2(o[4], o[5]), pk2(o[6], o[7])};
      u32x4 w1 = {pk2(o[8], o[9]), pk2(o[10], o[11]), pk2(o[12], o[13]), pk2(o[14], o[15])};
      u32x4* d = (u32x4*)(OF + row * 1024 + lane * 16);
      d[0] = w0; d[1] = w1; }
  }
}
DI void phase_combine(const Params& p) {
  const int tid = threadIdx.x, lane = tid & 63;
  bf16_t* MO = (bf16_t*)(p.ws + OFF_PROJA);
  const bf16_t* P1 = (const bf16_t*)(p.out + DO_P1);
  const float* L0 = (const float*)(p.out + DO_LSE); const float* L1 = L0 + 8 * N_SSPLIT * 256;
  const int gw = blockIdx.x * 8 + (tid >> 6), nw = gridDim.x * 8;
  for (int j = gw; j < 8 * N_SSPLIT * 256; j += nw) {
    const int si = j >> 8, h = si / N_SSPLIT, blk = 64 - N_SSPLIT + (si % N_SSPLIT);
    const long row = (long)TP + blk * 256 + (j & 255);
    const float l0 = L0[j], l1 = L1[j], m = fmaxf(l0, l1);
    const float w0 = __builtin_amdgcn_exp2f(l0 - m), w1 = __builtin_amdgcn_exp2f(l1 - m), inv = __builtin_amdgcn_rcpf(w0 + w1);
    unsigned* d = (unsigned*)(MO + row * 1024 + h * 128) + lane;
    const unsigned a = *d, b = ((const unsigned*)(P1 + (long)j * 1024))[lane];
    *d = pk2((w0 * bflo(a) + w1 * bflo(b)) * inv, (w0 * bfhi(a) + w1 * bfhi(b)) * inv);
  }
}
DI void phase_e1(const Params& p) {
  const int tid = threadIdx.x, lane = tid & 63;
  const bf16_t* MIX = (const bf16_t*)(p.ws + OFF_MIX);
  bf16_t* XB1 = (bf16_t*)(p.ws + OFF_XB);
  float* X1 = (float*)p.out; float* rs2 = (float*)(p.ws + OFF_RS2);
  const float* ssqm = (const float*)(p.ws + OFF_SSQM);
  const int gw = blockIdx.x * 8 + (tid >> 6), nw = gridDim.x * 8;
  f32x4 gv[8];
#pragma unroll
  for (int i = 0; i < 8; ++i) gv[i] = *(const f32x4*)(p.post_mix + (i * 64 + lane) * 4);
  for (int row0 = gw; row0 < T; row0 += 2 * nw) {
    const int row1 = row0 + nw;
    const float* src0 = row0 < TP ? p.x0 + (size_t)row0 * DM : p.x1 + (size_t)(row0 - TP) * DM;
    const float* src1 = row1 < TP ? p.x0 + (size_t)row1 * DM : p.x1 + (size_t)(row1 - TP) * DM;
    float sp0 = lane < 32 ? ssqm[(size_t)row0 * 32 + lane] : 0.f, sp1 = lane < 32 ? ssqm[(size_t)row1 * 32 + lane] : 0.f;
    f32x4 xa[8], xb[8]; u32x2 ma[8], mb[8];
#pragma unroll
    for (int i = 0; i < 8; ++i) { const int c = (i * 64 + lane) * 4;
      xa[i] = __builtin_nontemporal_load((const f32x4*)(src0 + c)); ma[i] = __builtin_nontemporal_load((const u32x2*)(MIX + (size_t)row0 * DM + c));
      xb[i] = __builtin_nontemporal_load((const f32x4*)(src1 + c)); mb[i] = __builtin_nontemporal_load((const u32x2*)(MIX + (size_t)row1 * DM + c)); }
    sp0 = wave_sum(sp0); sp1 = wave_sum(sp1);
    const float ra = __builtin_amdgcn_rsqf(sp0 * (1.0f / DM) + EPS), rb = __builtin_amdgcn_rsqf(sp1 * (1.0f / DM) + EPS);
    float sa = 0.f, sb = 0.f;
#pragma unroll
    for (int i = 0; i < 8; ++i) { const int c = (i * 64 + lane) * 4;
      f32x4 y, z;
      y[0] = xa[i][0] + bflo(ma[i][0]) * ra * gv[i][0]; y[1] = xa[i][1] + bfhi(ma[i][0]) * ra * gv[i][1];
      y[2] = xa[i][2] + bflo(ma[i][1]) * ra * gv[i][2]; y[3] = xa[i][3] + bfhi(ma[i][1]) * ra * gv[i][3];
      z[0] = xb[i][0] + bflo(mb[i][0]) * rb * gv[i][0]; z[1] = xb[i][1] + bfhi(mb[i][0]) * rb * gv[i][1];
      z[2] = xb[i][2] + bflo(mb[i][1]) * rb * gv[i][2]; z[3] = xb[i][3] + bfhi(mb[i][1]) * rb * gv[i][3];
      sa += y[0] * y[0] + y[1] * y[1] + y[2] * y[2] + y[3] * y[3];
      sb += z[0] * z[0] + z[1] * z[1] + z[2] * z[2] + z[3] * z[3];
      u32x2 w0 = {pk2(y[0], y[1]), pk2(y[2], y[3])}, w1 = {pk2(z[0], z[1]), pk2(z[2], z[3])};
      *(u32x2*)(XB1 + (size_t)row0 * DM + c) = w0; *(u32x2*)(XB1 + (size_t)row1 * DM + c) = w1; }
    sa = wave_sum(sa); sb = wave_sum(sb);
    if (lane == 0) { rs2[row0] = __builtin_amdgcn_rsqf(sa * (1.0f / DM) + EPS); rs2[row1] = __builtin_amdgcn_rsqf(sb * (1.0f / DM) + EPS); }
  }
}
DI void phase_e2(const Params& p) {
  const int tid = threadIdx.x, lane = tid & 63;
  const bf16_t* XB1 = (const bf16_t*)(p.ws + OFF_XB);
  float* OUT = (float*)p.out;
  const float* ssqm = (const float*)(p.ws + OFF_SSQM);
  const int gw = blockIdx.x * 8 + (tid >> 6), nw = gridDim.x * 8;
  f32x4 gv[8];
#pragma unroll
  for (int i = 0; i < 8; ++i) gv[i] = *(const f32x4*)(p.post_mlp + (i * 64 + lane) * 4);
  for (int row0 = gw; row0 < T; row0 += 2 * nw) {
    const int row1 = row0 + nw;
    float sp0 = lane < 32 ? ssqm[(size_t)row0 * 32 + lane] : 0.f, sp1 = lane < 32 ? ssqm[(size_t)row1 * 32 + lane] : 0.f;
    u32x2 xa[8], xb[8], fa[8], fb[8];
#pragma unroll
    for (int i = 0; i < 8; ++i) { const int c = (i * 64 + lane) * 4;
      xa[i] = __builtin_nontemporal_load((const u32x2*)(XB1 + (size_t)row0 * DM + c)); fa[i] = __builtin_nontemporal_load((const u32x2*)((const bf16_t*)(OUT + (size_t)row0 * DM) + c));
      xb[i] = __builtin_nontemporal_load((const u32x2*)(XB1 + (size_t)row1 * DM + c)); fb[i] = __builtin_nontemporal_load((const u32x2*)((const bf16_t*)(OUT + (size_t)row1 * DM) + c)); }
    sp0 = wave_sum(sp0); sp1 = wave_sum(sp1);
    const float ra = __builtin_amdgcn_rsqf(sp0 * (1.0f / DM) + EPS), rb = __builtin_amdgcn_rsqf(sp1 * (1.0f / DM) + EPS);
    f32x4 ya[8], yb[8];
#pragma unroll
    for (int i = 0; i < 8; ++i) {
      ya[i][0] = bflo(xa[i][0]) + bflo(fa[i][0]) * ra * gv[i][0]; ya[i][1] = bfhi(xa[i][0]) + bfhi(fa[i][0]) * ra * gv[i][1];
      ya[i][2] = bflo(xa[i][1]) + bflo(fa[i][1]) * ra * gv[i][2]; ya[i][3] = bfhi(xa[i][1]) + bfhi(fa[i][1]) * ra * gv[i][3];
      yb[i][0] = bflo(xb[i][0]) + bflo(fb[i][0]) * rb * gv[i][0]; yb[i][1] = bfhi(xb[i][0]) + bfhi(fb[i][0]) * rb * gv[i][1];
      yb[i][2] = bflo(xb[i][1]) + bflo(fb[i][1]) * rb * gv[i][2]; yb[i][3] = bfhi(xb[i][1]) + bfhi(fb[i][1]) * rb * gv[i][3]; }
    asm volatile("s_waitcnt vmcnt(0)" ::: "memory");
#pragma unroll
    for (int i = 0; i < 8; ++i) { const int c = (i * 64 + lane) * 4;
      __builtin_nontemporal_store(ya[i], (f32x4*)(OUT + (size_t)row0 * DM + c)); __builtin_nontemporal_store(yb[i], (f32x4*)(OUT + (size_t)row1 * DM + c)); }
  }
}

DI void phase_mixer(const Params& p, char* lds) {
  unsigned* ctr = (unsigned*)(p.ws + OFF_CTR);
  int* sh = (int*)(lds + 157696);
  const bf16_t* Q = (const bf16_t*)(p.out + DO_Q);
  const bf16_t* KV = (const bf16_t*)(p.ws + OFF_XB);
  const bf16_t* KPE = (const bf16_t*)(p.ws + OFF_KPE);
  bf16_t* MO = (bf16_t*)(p.ws + OFF_PROJA);
  const int xcd = blockIdx.x & 7;
  for (int d = 0; d < 8; ++d) {
    const int y = (xcd + d) & 7;
    for (;;) {
      __syncthreads();
      if (threadIdx.x == 0) *sh = (int)atomicAdd(ctr + 32 * y, 1u);
      __syncthreads();
      const int v = *sh;
      if (v >= 6) break;
#ifndef NO_GLA
      gla_task(p, v < 2 ? 2 * y + v : 16 + 4 * y + (v - 2), lds);
#endif
    }
  }
  for (int d = 0; d < 8; ++d) {
    const int y = (xcd + d) & 7;
    for (;;) {
      __syncthreads();
      if (threadIdx.x == 0) *sh = (int)atomicAdd(ctr + 256 + 32 * y, 1u);
      __syncthreads();
      const int v = *sh;
      if (v >= N_ATTQ) break;
      int seqstart, len, blk, kbeg = 0; float* lse = nullptr; const int h = y;
      bf16_t* ob = nullptr;
      if (v < 64 - N_SSPLIT) { seqstart = TP; len = 16384; blk = v; }
      else if (v < 64 + N_SSPLIT) {
        const int w = v - (64 - N_SSPLIT), i = w >> 1, half = w & 1, si = y * N_SSPLIT + i;
        seqstart = TP; len = 8192; kbeg = half * 8192; blk = 64 - N_SSPLIT + i;
        lse = (float*)(p.out + DO_LSE) + half * (8 * N_SSPLIT * 256) + si * 256;
        if (half) ob = (bf16_t*)(p.out + DO_P1) + (long)si * 256 * 1024;
      } else { const int v2 = v - (64 + N_SSPLIT); seqstart = (v2 >> 4) * 4096; len = 4096; blk = v2 & 15; }
      const long q0 = (long)seqstart + blk * 256, k0 = (long)seqstart + kbeg;
      if (ob == nullptr) ob = MO + q0 * 1024 + h * 128;
#ifndef NO_ATT
      attn_unit(Q + q0 * 1536 + h * 192, KV + k0 * 2048 + h * 256, KV + k0 * 2048 + h * 256 + 128, KPE + k0 * 64, ob, len, lse, lds);
#endif
    }
  }
  for (;;) {
    __syncthreads();
    if (threadIdx.x == 0) *sh = (int)atomicAdd(ctr + 512, 4u);
    __syncthreads();
    const int t0 = *sh;
    if (t0 >= N_LATE) break;
    conv_late_tile4(p, t0, lds);
  }
}

DI void gbar(unsigned* bar, unsigned k, char* lds) {
  asm volatile("s_waitcnt vmcnt(0)" ::: "memory");
  __syncthreads();
  if (threadIdx.x == 0) {
    volatile unsigned* st = (volatile unsigned*)(lds + 157696 + 64);
    const unsigned x = (unsigned)__builtin_amdgcn_s_getreg((3 << 11) | 20) & 0xFu;
    unsigned nloc, nx;
    if (k == 1u) {
      unsigned spins = 0;
      for (;;) {
        unsigned sum = 0, cnt = 0, mine = 0;
        for (unsigned j = 0; j < 16; ++j) { const unsigned c = __hip_atomic_load(bar + 2048 + 64 * j, __ATOMIC_RELAXED, __HIP_MEMORY_SCOPE_AGENT); sum += c; cnt += c ? 1u : 0u; mine = j == x ? c : mine; }
        nloc = mine ? mine : 1u; nx = cnt ? cnt : 1u;
        if (sum == gridDim.x || ++spins > (1u << 20)) break;
        __builtin_amdgcn_s_sleep(1);
      }
      st[0] = nloc; st[1] = nx;
    } else { nloc = st[0]; nx = st[1]; }
    const unsigned old = __hip_atomic_fetch_add(bar + 128 + 64 * x, 1u, __ATOMIC_RELAXED, __HIP_MEMORY_SCOPE_AGENT);
    if (old + 1u == k * nloc) {
      __builtin_amdgcn_fence(__ATOMIC_RELEASE, "agent");
      asm volatile("s_waitcnt vmcnt(0)" ::: "memory");
      const unsigned og = __hip_atomic_fetch_add(bar, 1u, __ATOMIC_RELAXED, __HIP_MEMORY_SCOPE_AGENT);
      if (og + 1u == k * nx) __hip_atomic_store(bar + 64, k, __ATOMIC_RELAXED, __HIP_MEMORY_SCOPE_AGENT);
    }
    { unsigned spins = 0; while (__hip_atomic_load(bar + 64, __ATOMIC_RELAXED, __HIP_MEMORY_SCOPE_AGENT) < k) { __builtin_amdgcn_s_sleep(1); if (++spins > (1u << 22)) break; } }
    __builtin_amdgcn_fence(__ATOMIC_ACQUIRE, "agent");
    asm volatile("s_waitcnt vmcnt(0)" ::: "memory");
  }
  __syncthreads();
}

__global__ void __launch_bounds__(512) mega(Params p, int ph_lo, int ph_hi) {
  extern __shared__ __attribute__((aligned(16))) char lds[];
  cg::grid_group grid = cg::this_grid();
#ifndef PH_MASK
#define PH_MASK 0xfff
#endif
#define PHASE(k, ...) if (((PH_MASK >> k) & 1) && ph_lo <= k && k < ph_hi) { if (k == 1) { grid.sync(); if (threadIdx.x == 0) __hip_atomic_fetch_add((unsigned*)(p.ws + OFF_CTR) + 1024 + 2048 + 64 * ((unsigned)__builtin_amdgcn_s_getreg((3 << 11) | 20) & 0xFu), 1u, __ATOMIC_RELAXED, __HIP_MEMORY_SCOPE_AGENT); } else if (k > 1) gbar((unsigned*)(p.ws + OFF_CTR) + 1024, (unsigned)(k - 1), lds); __VA_ARGS__; }
  PHASE(0, phase0(p, lds))
  PHASE(1, run_gemm<EP_IN>(p, lds, (const bf16_t*)(p.ws + OFF_XB), 2048, (const bf16_t*)(p.ws + OFF_WIN), T, NIN_PAD, 2048, 0); conv_idle_round(p, lds))
  PHASE(2, phase_kpe(p); run_gemm<EP_Q>(p, lds, (const bf16_t*)(p.ws + OFF_PROJA), 1024, (const bf16_t*)(p.ws + OFF_WQB), T, 1536, 512, 0);
           run_gemm<EP_KV>(p, lds, (const bf16_t*)(p.ws + OFF_PROJA) + 512, 1024, (const bf16_t*)(p.ws + OFF_WKVB), T, 2048, 512, 0))
  PHASE(3, phase_mixer(p, lds))
  PHASE(4, phase_combine(p); phase_e0(p))
  PHASE(5, run_gemm<EP_MIX>(p, lds, (const bf16_t*)(p.ws + OFF_PROJA), 1024, (const bf16_t*)(p.ws + OFF_WOUT), T, 2048, 2048, 0,
                            (long)((p.out + DO_OF) - (p.ws + OFF_PROJA)) - 2048, 16))
  PHASE(6, phase_e1(p))
  PHASE(7, run_gemm<EP_UP>(p, lds, (const bf16_t*)(p.ws + OFF_XB), 2048, (const bf16_t*)(p.ws + OFF_WUP), TP, DFF, 2048, 0))
  PHASE(8, run_gemm<EP_DOWN>(p, lds, (const bf16_t*)(p.ws + OFF_U), 8192, (const bf16_t*)(p.ws + OFF_WDOWN), TP, 2048, 8192, 0))
  PHASE(9, run_gemm<EP_UP>(p, lds, (const bf16_t*)(p.ws + OFF_XB) + (size_t)TP * 2048, 2048, (const bf16_t*)(p.ws + OFF_WUP), TP, DFF, 2048, TP))
  PHASE(10, run_gemm<EP_DOWN>(p, lds, (const bf16_t*)(p.ws + OFF_U), 8192, (const bf16_t*)(p.ws + OFF_WDOWN), TP, 2048, 8192, TP))
  PHASE(11, phase_e2(p))
}

extern "C" void kernel_launch(void* const* d_in, const int* in_sizes, int n_in, void* d_out, int out_size,
                              void* d_ws, size_t ws_size, hipStream_t stream) {
  static int grid_blocks = 0;
  if (!grid_blocks) {
    if (hipFuncSetAttribute((const void*)mega, hipFuncAttributeMaxDynamicSharedMemorySize, LDS_BYTES) != hipSuccess) fprintf(stderr, "set attr failed\n");
    int dev = 0, cus = 0, per_cu = 0;
    (void)hipGetDevice(&dev);
    (void)hipDeviceGetAttribute(&cus, hipDeviceAttributeMultiprocessorCount, dev);
    (void)hipOccupancyMaxActiveBlocksPerMultiprocessor(&per_cu, mega, 512, LDS_BYTES);
    if (per_cu < 1) { fprintf(stderr, "occupancy query returned %d\n", per_cu); per_cu = 1; }
    grid_blocks = cus;
  }
  if (n_in != 19 || ws_size < WS_NEED || out_size != T * DM) { fprintf(stderr, "kernel_launch: unexpected sizes n_in %d ws %zu out %d\n", n_in, ws_size, out_size); return; }
  Params p{};
  const float** pp = (const float**)&p;
  for (int i = 0; i < 19; ++i) pp[i] = (const float*)d_in[i];
  p.out = (char*)d_out; p.ws = (char*)d_ws;
  int lo = 0, hi = 12;
  void* args[] = {&p, &lo, &hi};
  hipError_t e = hipLaunchCooperativeKernel((void*)mega, dim3(grid_blocks), dim3(512), args, LDS_BYTES, stream);
  if (e != hipSuccess) fprintf(stderr, "cooperative launch failed: %s (grid %d)\n", hipGetErrorString(e), grid_blocks);
}
```

```cpp
#include <hip/hip_runtime.h>
#include <hip/hip_cooperative_groups.h>
#include <cstdio>
namespace cg = cooperative_groups;

#define DI __device__ __forceinline__
#define LAS __attribute__((address_space(3)))
typedef unsigned short bf16_t;
typedef short bf16x8 __attribute__((ext_vector_type(8)));
typedef short s16x4 __attribute__((ext_vector_type(4)));
typedef float f32x2 __attribute__((ext_vector_type(2)));
typedef float f32x4 __attribute__((ext_vector_type(4)));
typedef float f32x16 __attribute__((ext_vector_type(16)));
typedef unsigned u32x2 __attribute__((ext_vector_type(2)));
typedef unsigned u32x4 __attribute__((ext_vector_type(4)));
typedef __bf16 bfv2 __attribute__((ext_vector_type(2)));

constexpr int T = 32768, TP = 16384, DM = 2048, DFF = 8192;
constexpr float EPS = 1e-6f;
constexpr int NIN_PAD = 4352;
constexpr float QSCALE = 0.07216878364870323f * 1.4426950408889634f;
constexpr float GLA_QS = 0.08838834764831845f;

constexpr size_t MiB = 1u << 20;
constexpr size_t OFF_WIN = 0, OFF_WQB = 17 * MiB, OFF_WKVB = OFF_WQB + 3 * MiB / 2, OFF_WOUT = OFF_WKVB + 2 * MiB,
                 OFF_WUP = OFF_WOUT + 8 * MiB, OFF_WDOWN = OFF_WUP + 32 * MiB;
constexpr size_t OFF_RS0 = 93 * MiB, OFF_RS2 = OFF_RS0 + 128 * 1024, OFF_CTR = OFF_RS2 + 128 * 1024,
                 OFF_SSQA = 94 * MiB, OFF_SSQM = 96 * MiB, OFF_ROPE = 100 * MiB;
constexpr size_t OFF_PROJG = 104 * MiB;
constexpr size_t OFF_PROJS = 296 * MiB;
constexpr size_t OFF_PROJA = 312 * MiB;
constexpr size_t OFF_XB = 376 * MiB;
constexpr size_t OFF_KPE = 504 * MiB;
constexpr size_t OFF_MIX = 104 * MiB;
constexpr size_t OFF_U = 104 * MiB;
constexpr size_t WS_NEED = 512 * MiB;
constexpr size_t DO_Q = 0, DO_OF = 96 * MiB, DO_OB = 160 * MiB, DO_P1 = 224 * MiB, DO_LSE = 240 * MiB;

constexpr int LDS_BYTES = 157696 + 512;
constexpr int N_IDLE_LATE = 4 * 656;
constexpr int N_SSPLIT = 4, N_ATTQ = 64 + N_SSPLIT + 64;

struct Params {
  const float *x0, *x1, *w_in, *q_a_norm, *w_q_b, *kv_a_norm, *w_kv_b, *w_gk_f, *b_gk_f, *w_gk_b, *b_gk_b, *gla_norm, *w_out,
      *pre_mix, *post_mix, *pre_mlp, *post_mlp, *w_up, *w_down;
  char* out; char* ws;
};

__device__ const double ROPE_INV[32] = {
1.0, 0.7498942093324559, 0.5623413251903491, 0.4216965034285823,
0.31622776601683794, 0.23713737056616555, 0.1778279410038923, 0.1333521432163324,
0.1, 0.07498942093324558, 0.056234132519034905, 0.042169650342858224,
0.03162277660168379, 0.02371373705661655, 0.01778279410038923, 0.01333521432163324,
0.01, 0.007498942093324559, 0.005623413251903491, 0.004216965034285823,
0.00316227766016838, 0.0023713737056616554, 0.001778279410038923, 0.001333521432163324,
0.001, 0.0007498942093324559, 0.0005623413251903491, 0.0004216965034285823,
0.00031622776601683794, 0.00023713737056616554, 0.0001778279410038923, 0.0001333521432163324};

DI unsigned pk2(float a, float b) { f32x2 v = {a, b}; bfv2 r = __builtin_convertvector(v, bfv2); return __builtin_bit_cast(unsigned, r); }
DI float bflo(unsigned w) { return __uint_as_float(w << 16); }
DI float bfhi(unsigned w) { return __uint_as_float(w & 0xffff0000u); }
DI float bf2f(short h) { return __uint_as_float(((unsigned)(unsigned short)h) << 16); }
DI float wave_sum(float v) {
#pragma unroll
  for (int o = 32; o > 0; o >>= 1) v += __shfl_xor(v, o);
  return v;
}
DI int crow(int r, int hi) { return (r & 3) + 8 * (r >> 2) + 4 * hi; }
DI bf16x8 pack8(const f32x16& x, int s) {
  u32x4 w = {pk2(x[8 * s + 0], x[8 * s + 1]), pk2(x[8 * s + 2], x[8 * s + 3]), pk2(x[8 * s + 4], x[8 * s + 5]), pk2(x[8 * s + 6], x[8 * s + 7])};
  return __builtin_bit_cast(bf16x8, w);
}
#define MFMA32(a, b, c) __builtin_amdgcn_mfma_f32_32x32x16_bf16((a), (b), (c), 0, 0, 0)

DI int colmap_in(int n) {
  if (n < 1024) return n;
  if (n < 3072) return n + 64;
  if (n < 4096) return n + 96;
  if (n < 4160) return 1024 + (n - 4096);
  if (n < 4192) return 3136 + (n - 4160);
  return -1;
}
DI int colmap_qb(int n) {
  if (n < 1024) return (n >> 7) * 192 + (n & 127);
  const int m = n - 1024, h = m >> 6, r = m & 63;
  return h * 192 + 128 + (r >> 1) + 32 * (r & 1);
}
template <int CM>
DI void convT_tile(const float* __restrict__ src, int ldsrc, const float* __restrict__ gain, bf16_t* __restrict__ dst, int K, int k0, int n0, float* tile) {
  const int tid = threadIdx.x;
  {
    const int nn = tid & 63, kk0 = tid >> 6;
    const int n = n0 + nn;
    const int sc = CM == 1 ? colmap_in(n) : (CM == 2 ? colmap_qb(n) : n);
#pragma unroll
    for (int r = 0; r < 8; ++r) {
      const int kk = kk0 + 8 * r;
      float v = 0.f;
      if (sc >= 0) { v = src[(size_t)(k0 + kk) * ldsrc + sc]; if (gain) v *= gain[k0 + kk]; }
      tile[kk * 65 + nn] = v;
    }
  }
  __syncthreads();
  {
    const int kk8 = (tid & 7) * 8, n2 = tid >> 3;
    float v[8];
#pragma unroll
    for (int j = 0; j < 8; ++j) v[j] = tile[(kk8 + j) * 65 + n2];
    u32x4 w = {pk2(v[0], v[1]), pk2(v[2], v[3]), pk2(v[4], v[5]), pk2(v[6], v[7])};
    *(u32x4*)(dst + (size_t)(n0 + n2) * K + k0 + kk8) = w;
  }
  __syncthreads();
}

template <int CM>
DI void convT_tile4(const float* __restrict__ src, int ldsrc, const float* __restrict__ gain, bf16_t* __restrict__ dst, int K, int k0, int n0, float* tile) {
  const int tid = threadIdx.x;
  const int nn = tid & 63, kk0 = tid >> 6;
  const int sc = CM == 1 ? colmap_in(n0 + nn) : (CM == 2 ? colmap_qb(n0 + nn) : n0 + nn);
  float v[4][8];
#pragma unroll
  for (int t = 0; t < 4; ++t)
#pragma unroll
    for (int r = 0; r < 8; ++r) v[t][r] = sc >= 0 ? __builtin_nontemporal_load(src + (size_t)(k0 + 64 * t + kk0 + 8 * r) * ldsrc + sc) : 0.f;
  if (gain) {
#pragma unroll
    for (int t = 0; t < 4; ++t)
#pragma unroll
      for (int r = 0; r < 8; ++r) v[t][r] *= gain[k0 + 64 * t + kk0 + 8 * r];
  }
  const int kk8 = (tid & 7) * 8, n2 = tid >> 3;
#pragma unroll
  for (int t = 0; t < 4; ++t) {
#pragma unroll
    for (int r = 0; r < 8; ++r) tile[(kk0 + 8 * r) * 65 + nn] = v[t][r];
    __syncthreads();
    float w[8];
#pragma unroll
    for (int j = 0; j < 8; ++j) w[j] = tile[(kk8 + j) * 65 + n2];
    u32x4 o = {pk2(w[0], w[1]), pk2(w[2], w[3]), pk2(w[4], w[5]), pk2(w[6], w[7])};
    *(u32x4*)(dst + (size_t)(n0 + n2) * K + k0 + 64 * t + kk8) = o;
    __syncthreads();
  }
}

DI void phase0(const Params& p, char* lds) {
  const int tid = threadIdx.x, lane = tid & 63;
  char* ws = p.ws;
  if (blockIdx.x == 0) { for (int i = tid; i < 544; i += 512) ((unsigned*)(ws + OFF_CTR))[i] = i == 512 ? (unsigned)N_IDLE_LATE : 0u; for (int i = tid; i < 3200; i += 512) ((unsigned*)(ws + OFF_CTR))[1024 + i] = 0u; }
  {
    f32x2* tab = (f32x2*)(ws + OFF_ROPE);
    for (int idx = blockIdx.x * 512 + tid; idx < 16384 * 32; idx += gridDim.x * 512) {
      const int pos = idx >> 5, i = idx & 31;
      const double ang = (double)pos * ROPE_INV[i];
      const double kq = __builtin_rint(ang * 0.6366197723675814);
      double r = ang - kq * 1.5707963267948966;
      r = r - kq * 6.123233995736766e-17;
      const double r2 = r * r;
      double sn = r * (1.0 + r2 * (-1.0 / 6 + r2 * (1.0 / 120 + r2 * (-1.0 / 5040 + r2 * (1.0 / 362880 + r2 * (-1.0 / 39916800 + r2 * (1.0 / 6227020800.0)))))));
      double cs = 1.0 + r2 * (-0.5 + r2 * (1.0 / 24 + r2 * (-1.0 / 720 + r2 * (1.0 / 40320 + r2 * (-1.0 / 3628800 + r2 * (1.0 / 479001600.0 + r2 * (-1.0 / 87178291200.0)))))));
      const int q = ((int)kq) & 3;
      double c, s;
      if (q == 0) { c = cs; s = sn; } else if (q == 1) { c = -sn; s = cs; } else if (q == 2) { c = -cs; s = -sn; } else { c = sn; s = -cs; }
      tab[idx] = (f32x2){(float)c, (float)s};
    }
  }
  {
    bf16_t* XB = (bf16_t*)(ws + OFF_XB);
    float* rs0 = (float*)(ws + OFF_RS0);
    const int gw = blockIdx.x * 8 + (tid >> 6), nw = gridDim.x * 8;
    for (int row0 = gw; row0 < T; row0 += 2 * nw) {
      const int row1 = row0 + nw;
      const float* src0 = row0 < TP ? p.x0 + (size_t)row0 * DM : p.x1 + (size_t)(row0 - TP) * DM;
      const float* src1 = row1 < TP ? p.x0 + (size_t)row1 * DM : p.x1 + (size_t)(row1 - TP) * DM;
      f32x4 va[8], vb[8];
#pragma unroll
      for (int i = 0; i < 8; ++i) { va[i] = __builtin_nontemporal_load((const f32x4*)(src0 + (i * 64 + lane) * 4)); vb[i] = __builtin_nontemporal_load((const f32x4*)(src1 + (i * 64 + lane) * 4)); }
      float sa = 0.f, sb = 0.f;
#pragma unroll
      for (int i = 0; i < 8; ++i) {
        sa += va[i][0] * va[i][0] + va[i][1] * va[i][1] + va[i][2] * va[i][2] + va[i][3] * va[i][3];
        sb += vb[i][0] * vb[i][0] + vb[i][1] * vb[i][1] + vb[i][2] * vb[i][2] + vb[i][3] * vb[i][3];
        u32x2 w0 = {pk2(va[i][0], va[i][1]), pk2(va[i][2], va[i][3])}, w1 = {pk2(vb[i][0], vb[i][1]), pk2(vb[i][2], vb[i][3])};
        *(u32x2*)(XB + (size_t)row0 * DM + (i * 64 + lane) * 4) = w0;
        *(u32x2*)(XB + (size_t)row1 * DM + (i * 64 + lane) * 4) = w1;
      }
      sa = wave_sum(sa); sb = wave_sum(sb);
      if (lane == 0) { rs0[row0] = __builtin_amdgcn_rsqf(sa * (1.0f / DM) + EPS); rs0[row1] = __builtin_amdgcn_rsqf(sb * (1.0f / DM) + EPS); }
    }
  }
  {
    float* tile = (float*)lds;
    constexpr int NT = 32 * 68 / 4;
    for (int t = blockIdx.x; t < NT; t += gridDim.x) { const int u = 4 * t;
      convT_tile4<1>(p.w_in, 4192, p.pre_mix, (bf16_t*)(ws + OFF_WIN), 2048, (u & 31) * 64, (u >> 5) * 64, tile); }
  }
}
constexpr int NL3 = 32 * 32, NL4 = 32 * 128, NL5 = 128 * 32, N_LATE = NL3 + NL4 + NL5;
DI void conv_late_tile4(const Params& p, int t, char* lds) {
  float* tile = (float*)lds; char* ws = p.ws;
  int u = t;
  if (u < NL3) { convT_tile4<0>(p.w_out, 2048, nullptr, (bf16_t*)(ws + OFF_WOUT), 2048, (u & 31) * 64, (u >> 5) * 64, tile); return; }
  u -= NL3;
  if (u < NL4) { convT_tile4<0>(p.w_up, 8192, p.pre_mlp, (bf16_t*)(ws + OFF_WUP), 2048, (u & 31) * 64, (u >> 5) * 64, tile); return; }
  u -= NL4;
  convT_tile4<0>(p.w_down, 2048, nullptr, (bf16_t*)(ws + OFF_WDOWN), 8192, (u & 127) * 64, (u >> 7) * 64, tile);
}

DI void conv_idle_round(const Params& p, char* lds) {
  if (blockIdx.x < 128) return;
  float* tile = (float*)lds; char* ws = p.ws;
  __syncthreads();
  for (int g = (int)blockIdx.x - 128; g < 768; g += (int)gridDim.x - 128) {
    if (g < 48) { const int u = 4 * g; convT_tile4<2>(p.w_q_b, 1536, p.q_a_norm, (bf16_t*)(ws + OFF_WQB), 512, (u & 7) * 64, (u >> 3) * 64, tile); }
    else if (g < 112) { const int u = 4 * (g - 48); convT_tile4<0>(p.w_kv_b, 2048, p.kv_a_norm, (bf16_t*)(ws + OFF_WKVB), 512, (u & 7) * 64, (u >> 3) * 64, tile); }
    else conv_late_tile4(p, 4 * (g - 112), lds);
  }
}

namespace pg8 {
constexpr int BM = 256, BK = 64, HALF = 128, HTB = HALF * BK * 2, STAGE_BYTES = 8 * HTB, NXCD = 8, WGM = 8;
DI int lds_byte(int r, int c) { const int st = (r >> 4) * 2 + (c >> 5), rr = r & 15, cc = c & 31, ob = rr * 64 + cc * 2; return st * 1024 + (ob ^ (((ob >> 9) & 1) << 5)); }
DI void stage_rc(int b, int& R, int& C) { const int st = b / 1024, sb = b % 1024, swz = sb ^ (((sb >> 9) & 1) << 5); R = (st >> 1) * 16 + swz / 64; C = (st & 1) * 32 + (swz % 64) / 2; }
DI int perm32(int rho) { const int n = rho >> 4, i = rho & 15; return 8 * (i >> 2) + 4 * n + (i & 3); }
struct Unit { int pm, pn; };
struct Gemm { const bf16_t* A; const bf16_t* Bt; int M, N, K, lda; long segd; int tsplit; };
struct StaticOrder {
  int nM, nN, nwg, G, c, wgm;
  DI void init(int M, int N, int G_, int c_, int wgm_ = WGM) { nM = M / BM; nN = N / BM; nwg = nM * nN; G = G_; c = c_; wgm = wgm_; }
  DI bool next(int i, Unit& u) const {
    const long L = (long)i * G + c; if (L >= nwg) return false;
    int wgid = (int)L; { const int q = nwg / NXCD, r = nwg % NXCD, xcd = wgid % NXCD, off = wgid / NXCD; wgid = (xcd < r ? xcd * (q + 1) : r * (q + 1) + (xcd - r) * q) + off; }
    const int nig = wgm * nN, gid = wgid / nig, fm = gid * wgm, gsz = (nM - fm) < wgm ? (nM - fm) : wgm;
    u.pm = fm + ((wgid % nig) % gsz); u.pn = (wgid % nig) / gsz; return true;
  }
};

template <class Epi>
DI void gemm_phase(LAS unsigned char* lds, const Gemm g, const StaticOrder& S, const Epi& E) {
  const int tid = threadIdx.x, wid = __builtin_amdgcn_readfirstlane(tid >> 6), lane = tid & 63, wr = wid >> 2, wc = wid & 3, fr = lane & 15, fq = lane >> 4;
  const int K = g.K, nt = K / BK, lda = g.lda;
  unsigned voffA[2], voffB[2];
#pragma unroll
  for (int i = 0; i < 2; ++i) { int R, C; stage_rc(tid * 16 + i * 8192, R, C); const int Rb = (R & ~31) + perm32(R & 31);
    voffA[i] = (unsigned)(R * lda + C) * 2u; voffB[i] = (unsigned)(Rb * K + C) * 2u; }
  const size_t kstep = (size_t)(BK * 2);
  const size_t hstepA = (size_t)HALF * lda * 2, hstepB = (size_t)HALF * K * 2;
  const size_t tstepA = 2 * hstepA, tstepB = 2 * hstepB;
  const unsigned ldsw = (unsigned)wid * 1024u;
  const int aoff = lds_byte(wr * 64 + fr, fq * 8), boff = lds_byte(wc * 32 + fr, fq * 8);
  const int tsplit = g.tsplit; const long segd = g.segd;
#define PG8_AK(t) ((size_t)(t) * kstep + ((t) >= tsplit ? segd : 0))
#define PG8_SA(b, h) (((b) * 2 + (h)) * HTB)
#define PG8_SB(b, h) ((4 + (b) * 2 + (h)) * HTB)
#define PG8_STAGE(bufoff, gbase, voff) do { _Pragma("unroll") for (int _i = 0; _i < 2; ++_i) \
    __builtin_amdgcn_global_load_lds((const unsigned*)((const char*)(gbase) + (voff)[_i]), (LAS unsigned*)(lds + (bufoff) + ldsw + _i * 8192), 16, 0, 0); } while (0)
#define PG8_LDA(dst, b, h) do { _Pragma("unroll") for (int m = 0; m < 4; ++m) _Pragma("unroll") for (int k = 0; k < 2; ++k) dst[m][k] = *(const LAS bf16x8*)(lds + PG8_SA(b, h) + aoff + m * 2048 + k * 1024); } while (0)
#define PG8_LDB(dst, b, h) do { _Pragma("unroll") for (int n = 0; n < 2; ++n) _Pragma("unroll") for (int k = 0; k < 2; ++k) dst[n][k] = *(const LAS bf16x8*)(lds + PG8_SB(b, h) + boff + n * 2048 + k * 1024); } while (0)
#define PG8_MMA(ai, bj, At, Bt) do { __builtin_amdgcn_s_setprio(1); _Pragma("unroll") for (int m = 0; m < 4; ++m) _Pragma("unroll") for (int n = 0; n < 2; ++n) _Pragma("unroll") for (int k = 0; k < 2; ++k) \
    acc[ai][bj][m][n] = __builtin_amdgcn_mfma_f32_16x16x32_bf16(Bt[n][k], At[m][k], acc[ai][bj][m][n], 0, 0, 0); __builtin_amdgcn_s_setprio(0); } while (0)
#define PG8_WAIT_V(n) asm volatile("s_waitcnt vmcnt(" #n ")" ::: "memory")
#define PG8_WAIT_L(n) asm volatile("s_waitcnt lgkmcnt(" #n ")" ::: "memory")
#define PG8_BAR __builtin_amdgcn_s_barrier()
#define PG8_SCHED __builtin_amdgcn_sched_barrier(0)
  Unit cur, nxt; int ui = 0;
  if (!S.next(0, cur)) return;
  f32x4 acc[2][2][4][2];
#pragma unroll
  for (int a = 0; a < 2; ++a)
#pragma unroll
    for (int b = 0; b < 2; ++b)
#pragma unroll
      for (int m = 0; m < 4; ++m)
#pragma unroll
        for (int n = 0; n < 2; ++n) acc[a][b][m][n] = (f32x4){0.f, 0.f, 0.f, 0.f};
  bf16x8 At[4][2], B0[2][2], B1[2][2];
  const char* cA = (const char*)g.A + (size_t)cur.pm * tstepA; const char* cB = (const char*)g.Bt + (size_t)cur.pn * tstepB;
  PG8_STAGE(PG8_SB(0, 0), cB, voffB); PG8_STAGE(PG8_SA(0, 0), cA, voffA); PG8_STAGE(PG8_SB(0, 1), cB + hstepB, voffB); PG8_STAGE(PG8_SA(0, 1), cA + hstepA, voffA);
  if (wr == 1) PG8_BAR;
  PG8_WAIT_V(4); PG8_BAR;
  PG8_STAGE(PG8_SB(1, 0), cB + kstep, voffB); PG8_STAGE(PG8_SA(1, 0), cA + kstep, voffA); PG8_STAGE(PG8_SB(1, 1), cB + hstepB + kstep, voffB);
  PG8_WAIT_V(6); PG8_BAR;
  for (;;) {
    const bool has_next = S.next(ui + 1, nxt);
    const char* nA = has_next ? (const char*)g.A + (size_t)nxt.pm * tstepA : cA; const char* nB = has_next ? (const char*)g.Bt + (size_t)nxt.pn * tstepB : cB;
    for (int t = 0; t < nt; t += 2) {
      const bool last = (t == nt - 2);
      const char* a1 = cA + PG8_AK(t + 1);
      const char* a2 = last ? nA : cA + PG8_AK(t + 2); const char* b2 = last ? nB : cB + (size_t)(t + 2) * kstep;
      const char* a3 = a2 + kstep; const char* b3 = b2 + kstep;
      PG8_LDB(B0, 0, 0); PG8_SCHED; PG8_LDA(At, 0, 0); PG8_STAGE(PG8_SA(1, 1), a1 + hstepA, voffA);
      PG8_WAIT_L(8); PG8_BAR; PG8_WAIT_L(0); PG8_MMA(0, 0, At, B0); PG8_BAR; PG8_SCHED;
      PG8_LDB(B1, 0, 1); PG8_STAGE(PG8_SB(0, 0), b2, voffB);
      PG8_BAR; PG8_WAIT_L(0); PG8_MMA(0, 1, At, B1); PG8_BAR;
      PG8_LDA(At, 0, 1); PG8_STAGE(PG8_SA(0, 0), a2, voffA);
      PG8_BAR; PG8_WAIT_L(0); PG8_MMA(1, 0, At, B0); PG8_BAR; PG8_SCHED;
      PG8_STAGE(PG8_SB(0, 1), b2 + hstepB, voffB);
      PG8_WAIT_V(6); PG8_BAR; PG8_MMA(1, 1, At, B1); PG8_BAR;
      PG8_LDB(B0, 1, 0); PG8_SCHED; PG8_LDA(At, 1, 0); PG8_STAGE(PG8_SA(0, 1), a2 + hstepA, voffA);
      PG8_WAIT_L(8); PG8_BAR; PG8_WAIT_L(0); PG8_MMA(0, 0, At, B0); PG8_BAR; PG8_SCHED;
      PG8_LDB(B1, 1, 1); PG8_STAGE(PG8_SB(1, 0), b3, voffB);
      PG8_BAR; PG8_WAIT_L(0); PG8_MMA(0, 1, At, B1); PG8_BAR;
      PG8_LDA(At, 1, 1); PG8_STAGE(PG8_SA(1, 0), a3, voffA);
      PG8_BAR; PG8_WAIT_L(0); PG8_MMA(1, 0, At, B0); PG8_BAR; PG8_SCHED;
      PG8_STAGE(PG8_SB(1, 1), b3 + hstepB, voffB);
      PG8_WAIT_V(6); PG8_BAR; PG8_MMA(1, 1, At, B1); PG8_BAR;
    }
    E(acc, cur, wr, wc, fr, fq);
    if (!has_next) break;
#pragma unroll
    for (int a = 0; a < 2; ++a)
#pragma unroll
      for (int b = 0; b < 2; ++b)
#pragma unroll
        for (int m = 0; m < 4; ++m)
#pragma unroll
          for (int n = 0; n < 2; ++n) acc[a][b][m][n] = (f32x4){0.f, 0.f, 0.f, 0.f};
    cur = nxt; cA = nA; cB = nB; ++ui;
  }
  PG8_WAIT_V(0);
  if (wr == 0) PG8_BAR;
  PG8_BAR;
#undef PG8_AK
#undef PG8_SA
#undef PG8_SB
#undef PG8_STAGE
#undef PG8_LDA
#undef PG8_LDB
#undef PG8_MMA
#undef PG8_WAIT_V
#undef PG8_WAIT_L
#undef PG8_BAR
#undef PG8_SCHED
}
}

enum { EP_IN = 0, EP_Q = 1, EP_KV = 2, EP_MIX = 3, EP_UP = 4, EP_DOWN = 5 };
template <int MODE> struct Epi {
  char* ws; char* dout; int rowbase;
  DI void operator()(const f32x4 (&acc)[2][2][4][2], const pg8::Unit& u, int wr, int wc, int fr, int fq) const {
    const int pn = u.pn;
    const int cl = wc * 32 + 8 * fq;
#pragma unroll
    for (int ai = 0; ai < 2; ++ai)
#pragma unroll
      for (int m = 0; m < 4; ++m) {
        const int row = u.pm * 256 + ai * 128 + wr * 64 + m * 16 + fr;
        const int grow = rowbase + row;
        float rs = 1.f;
        if (MODE == EP_IN) rs = ((const float*)(ws + OFF_RS0))[grow];
        if (MODE == EP_UP) rs = ((const float*)(ws + OFF_RS2))[grow];
        if (MODE == EP_Q || MODE == EP_KV) {
          const f32x4* sp = (const f32x4*)(ws + OFF_SSQA) + (size_t)grow * 4 + (MODE == EP_KV ? 2 : 0);
          const f32x4 s0 = sp[0], s1 = sp[1];
          const float ss = (s0[0] + s0[1]) + (s0[2] + s0[3]) + (s1[0] + s1[1]) + (s1[2] + s1[3]);
          rs = __builtin_amdgcn_rsqf(ss * (1.0f / 512) + EPS);
          if (MODE == EP_Q) rs *= QSCALE;
        }
        float ssq = 0.f;
#pragma unroll
        for (int bj = 0; bj < 2; ++bj) {
          f32x4 v0 = acc[ai][bj][m][0] * rs, v1 = acc[ai][bj][m][1] * rs;
          if (MODE == EP_IN || MODE == EP_MIX || MODE == EP_DOWN) {
#pragma unroll
            for (int j = 0; j < 4; ++j) ssq += v0[j] * v0[j] + v1[j] * v1[j];
          }
          if (MODE == EP_UP) {
#pragma unroll
            for (int j = 0; j < 4; ++j) { float a = fmaxf(v0[j], 0.f), b = fmaxf(v1[j], 0.f); v0[j] = a * a; v1[j] = b * b; }
          }
          bf16_t* dst;
          const int ct = bj * 128 + cl;
          if (MODE == EP_IN) {
            if (pn < 4) dst = (bf16_t*)(ws + OFF_PROJA) + (size_t)grow * 1024 + pn * 256 + ct;
            else if (pn < 16) dst = (bf16_t*)(ws + OFF_PROJG) + (size_t)grow * 3072 + (pn - 4) * 256 + ct;
            else dst = (bf16_t*)(ws + OFF_PROJS) + (size_t)grow * 256 + ct;
          } else if (MODE == EP_Q) {
            if (pn < 4) dst = (bf16_t*)(dout + DO_Q) + (size_t)grow * 1536 + (pn * 2 + bj) * 192 + cl;
            else {
              const int mm = (pn - 4) * 256 + ct, h = mm >> 6, r = mm & 63;
              dst = (bf16_t*)(dout + DO_Q) + (size_t)grow * 1536 + h * 192 + 128 + r;
              const int pos = grow < TP ? (grow & 4095) : grow - TP;
              const f32x4* tb = (const f32x4*)((const f32x2*)(ws + OFF_ROPE) + pos * 32 + (r >> 1));
              const f32x4 t0 = tb[0], t1 = tb[1];
              f32x4 o0, o1;
              o0[0] = v0[0] * t0[0] - v0[1] * t0[1]; o0[1] = v0[1] * t0[0] + v0[0] * t0[1];
              o0[2] = v0[2] * t0[2] - v0[3] * t0[3]; o0[3] = v0[3] * t0[2] + v0[2] * t0[3];
              o1[0] = v1[0] * t1[0] - v1[1] * t1[1]; o1[1] = v1[1] * t1[0] + v1[0] * t1[1];
              o1[2] = v1[2] * t1[2] - v1[3] * t1[3]; o1[3] = v1[3] * t1[2] + v1[2] * t1[3];
              v0 = o0; v1 = o1;
            }
          } else if (MODE == EP_KV) {
            dst = (bf16_t*)(ws + OFF_XB) + (size_t)grow * 2048 + pn * 256 + ct;
          } else if (MODE == EP_MIX) {
            dst = (bf16_t*)(ws + OFF_MIX) + (size_t)grow * 2048 + pn * 256 + ct;
          } else if (MODE == EP_UP) {
            dst = (bf16_t*)(ws + OFF_U) + (size_t)row * 8192 + pn * 256 + ct;
          } else {
            dst = (bf16_t*)dout + (size_t)grow * 4096 + pn * 256 + ct;
          }
          u32x4 w = {pk2(v0[0], v0[1]), pk2(v0[2], v0[3]), pk2(v1[0], v1[1]), pk2(v1[2], v1[3])};
          *(u32x4*)dst = w;
        }
        if (MODE == EP_IN || MODE == EP_MIX || MODE == EP_DOWN) {
          ssq += __shfl_xor(ssq, 16); ssq += __shfl_xor(ssq, 32);
          if (fq == 0) {
            if (MODE == EP_IN) { if (pn < 4) ((float*)(ws + OFF_SSQA))[(size_t)grow * 16 + pn * 4 + wc] = ssq; }
            else ((float*)(ws + OFF_SSQM))[(size_t)grow * 32 + pn * 4 + wc] = ssq;
          }
        }
      }
  }
};

template <int MODE>
DI void run_gemm(const Params& p, char* lds, const bf16_t* A, int lda, const bf16_t* Bt, int M, int N, int K, int rowbase, long segd = 0, int tsplit = 1 << 30) {
  pg8::Gemm g; g.A = A; g.Bt = Bt; g.M = M; g.N = N; g.K = K; g.lda = lda; g.segd = segd; g.tsplit = tsplit;
  pg8::StaticOrder S; S.init(M, N, gridDim.x, blockIdx.x, MODE == EP_UP ? 4 : pg8::WGM);
  Epi<MODE> E; E.ws = p.ws; E.dout = p.out; E.rowbase = rowbase;
  pg8::gemm_phase((LAS unsigned char*)lds, g, S, E);
}

constexpr int A_SHM_V = 64 * 128 * 2, A_SHM_K = 64 * 128 * 2, A_SHM_P = 64 * 64 * 2;
#define KSWZ(row, colB) ((row) * 256 + ((colB) ^ (((row) & 15) << 4)))
#define PSWZ(row, colB) ((row) * 128 + ((colB) ^ ((((row) >> 1) & 7) << 4)))
#define SBAR() __builtin_amdgcn_sched_barrier(0)
constexpr float ATH = 11.5f;
DI void a_partialSM(f32x16& p0, f32x16& p1, float& m_reg, float& mn, float& alpha) {
  float pmax = p0[0];
#pragma unroll
  for (int r = 1; r < 16; ++r) pmax = fmaxf(pmax, p0[r]);
#pragma unroll
  for (int r = 0; r < 16; ++r) pmax = fmaxf(pmax, p1[r]);
  { auto rr = __builtin_amdgcn_permlane32_swap(__float_as_uint(pmax), __float_as_uint(pmax), false, false);
    pmax = fmaxf(__uint_as_float(rr[0]), __uint_as_float(rr[1])); }
  if (__builtin_expect(__all(pmax - m_reg <= ATH), 1)) { mn = m_reg; alpha = 1.f; }
  else { mn = fmaxf(m_reg, pmax); alpha = __builtin_amdgcn_exp2f(m_reg - mn); m_reg = mn; }
#pragma unroll
  for (int r = 0; r < 16; ++r) p0[r] = p0[r] - mn;
#pragma unroll
  for (int r = 0; r < 16; ++r) p1[r] = p1[r] - mn;
#pragma unroll
  for (int r = 0; r < 16; ++r) p0[r] = __builtin_amdgcn_exp2f(p0[r]);
}
DI void a_finishSM(f32x16& p0, f32x16& p1, float alpha, float& l_reg, bf16x8& pa0, bf16x8& pa1, bf16x8& pa2, bf16x8& pa3) {
#pragma unroll
  for (int r = 0; r < 16; ++r) p1[r] = __builtin_amdgcn_exp2f(p1[r]);
  float ps = 0;
#pragma unroll
  for (int r = 0; r < 16; ++r) ps += p0[r];
#pragma unroll
  for (int r = 0; r < 16; ++r) ps += p1[r];
  { auto rr = __builtin_amdgcn_permlane32_swap(__float_as_uint(ps), __float_as_uint(ps), false, false);
    ps = __uint_as_float(rr[0]) + __uint_as_float(rr[1]); }
  l_reg = l_reg * alpha + ps;
#define PK4(P, BASE, OUT) do { unsigned a0 = pk2(P[BASE + 0], P[BASE + 1]), a1 = pk2(P[BASE + 2], P[BASE + 3]);   \
    unsigned b0 = pk2(P[BASE + 4], P[BASE + 5]), b1 = pk2(P[BASE + 6], P[BASE + 7]);                              \
    auto r0 = __builtin_amdgcn_permlane32_swap(a0, b0, false, false); auto r1 = __builtin_amdgcn_permlane32_swap(a1, b1, false, false); \
    u32x4 w = {r0[0], r1[0], r0[1], r1[1]}; OUT = __builtin_bit_cast(bf16x8, w); } while (0)
  PK4(p0, 0, pa0); PK4(p0, 8, pa1); PK4(p1, 0, pa2); PK4(p1, 8, pa3);
#undef PK4
}
DI void a_qkt(f32x16& p0, f32x16& p1, const char* Ks, const char* Ps, const bf16x8* qr, const char* QP, int r32, int hi) {
  p0 = f32x16{}; p1 = f32x16{};
#pragma unroll
  for (int d0 = 0; d0 < 8; ++d0) { const int cb = (d0 * 16 + hi * 8) * 2;
    bf16x8 b0 = *reinterpret_cast<const bf16x8*>(Ks + KSWZ(r32, cb));
    bf16x8 b1 = *reinterpret_cast<const bf16x8*>(Ks + KSWZ(32 + r32, cb));
    p0 = MFMA32(b0, qr[d0], p0);
    p1 = MFMA32(b1, qr[d0], p1); }
#pragma unroll
  for (int d0 = 0; d0 < 4; ++d0) { const int cb = (d0 * 16 + hi * 8) * 2;
    bf16x8 b0 = *reinterpret_cast<const bf16x8*>(Ps + PSWZ(r32, cb));
    bf16x8 b1 = *reinterpret_cast<const bf16x8*>(Ps + PSWZ(32 + r32, cb));
    const bf16x8 qp = *reinterpret_cast<const bf16x8*>(QP + d0 * 1024);
    p0 = MFMA32(b0, qp, p0);
    p1 = MFMA32(b1, qp, p1); }
}
DI int v_st(int k, int c) { const int kk = (k & ~0xC) | ((k & 4) << 1) | ((k & 8) >> 1); return ((kk >> 3) * 4 + (c >> 5)) * 512 + ((kk & 7) * 32 + (c & 31)) * 2; }
DI int v_rd_base(int lane) { return ((lane & 3) << 3) | (((lane >> 2) & 3) << 6) | (((lane >> 4) & 1) << 5) | (((lane >> 5) & 1) << 8); }
constexpr int v_rd_off(int d0, int ks, int half) { return d0 * 512 + ks * 4096 + half * 2048; }
template <int OFF> DI s16x4 tr_read(int vb) {
  s16x4 r; asm volatile("ds_read_b64_tr_b16 %0, %1 offset:%2" : "=&v"(r) : "v"(vb), "i"(OFF) : "memory"); return r;
}
template <int D0> DI void pv_one(f32x16& od, int vb, bf16x8 pa0, bf16x8 pa1, bf16x8 pa2, bf16x8 pa3) {
  const s16x4 l0 = tr_read<v_rd_off(D0, 0, 0)>(vb), h0 = tr_read<v_rd_off(D0, 0, 1)>(vb), l1 = tr_read<v_rd_off(D0, 1, 0)>(vb), h1 = tr_read<v_rd_off(D0, 1, 1)>(vb);
  const s16x4 l2 = tr_read<v_rd_off(D0, 2, 0)>(vb), h2 = tr_read<v_rd_off(D0, 2, 1)>(vb), l3 = tr_read<v_rd_off(D0, 3, 0)>(vb), h3 = tr_read<v_rd_off(D0, 3, 1)>(vb);
  asm volatile("s_waitcnt lgkmcnt(0)" ::: "memory"); SBAR();
#define PKV(L, H) (bf16x8){L[0], L[1], L[2], L[3], H[0], H[1], H[2], H[3]}
  od = MFMA32(pa0, PKV(l0, h0), od);
  od = MFMA32(pa1, PKV(l1, h1), od);
  od = MFMA32(pa2, PKV(l2, h2), od);
  od = MFMA32(pa3, PKV(l3, h3), od);
#undef PKV
}
DI void pv_d0(f32x16* o, int vb, bf16x8 pa0, bf16x8 pa1, bf16x8 pa2, bf16x8 pa3) {
  pv_one<0>(o[0], vb, pa0, pa1, pa2, pa3); pv_one<1>(o[1], vb, pa0, pa1, pa2, pa3); pv_one<2>(o[2], vb, pa0, pa1, pa2, pa3); pv_one<3>(o[3], vb, pa0, pa1, pa2, pa3);
}

#define PV_BLOCK(D0) { \
    const s16x4 l0 = tr_read<v_rd_off(D0, 0, 0)>(vb), h0 = tr_read<v_rd_off(D0, 0, 1)>(vb), l1 = tr_read<v_rd_off(D0, 1, 0)>(vb), h1 = tr_read<v_rd_off(D0, 1, 1)>(vb); \
    const s16x4 l2 = tr_read<v_rd_off(D0, 2, 0)>(vb), h2 = tr_read<v_rd_off(D0, 2, 1)>(vb), l3 = tr_read<v_rd_off(D0, 3, 0)>(vb), h3 = tr_read<v_rd_off(D0, 3, 1)>(vb); \
    asm volatile("s_waitcnt lgkmcnt(0)" ::: "memory"); SBAR(); \
    o[D0] = MFMA32(pa0, ((bf16x8){l0[0], l0[1], l0[2], l0[3], h0[0], h0[1], h0[2], h0[3]}), o[D0]); \
    o[D0] = MFMA32(pa1, ((bf16x8){l1[0], l1[1], l1[2], l1[3], h1[0], h1[1], h1[2], h1[3]}), o[D0]); \
    o[D0] = MFMA32(pa2, ((bf16x8){l2[0], l2[1], l2[2], l2[3], h2[0], h2[1], h2[2], h2[3]}), o[D0]); \
    o[D0] = MFMA32(pa3, ((bf16x8){l3[0], l3[1], l3[2], l3[3], h3[0], h3[1], h3[2], h3[3]}), o[D0]); }
DI void pv_sm(f32x16* o, int vb, bf16x8 pa0, bf16x8 pa1, bf16x8 pa2, bf16x8 pa3, f32x16& p0, f32x16& p1, float& m_reg, float& mn, float& alpha) {
  PV_BLOCK(0)
  float pm0 = p0[0];
#pragma unroll
  for (int r = 1; r < 16; ++r) pm0 = fmaxf(pm0, p0[r]);
  PV_BLOCK(1)
  float pmax = pm0;
#pragma unroll
  for (int r = 0; r < 16; ++r) pmax = fmaxf(pmax, p1[r]);
  { auto rr = __builtin_amdgcn_permlane32_swap(__float_as_uint(pmax), __float_as_uint(pmax), false, false);
    pmax = fmaxf(__uint_as_float(rr[0]), __uint_as_float(rr[1])); }
  const bool keep = __all(pmax - m_reg <= ATH);
  mn = keep ? m_reg : fmaxf(m_reg, pmax);
  alpha = __builtin_amdgcn_exp2f(m_reg - mn);
  m_reg = mn;
  PV_BLOCK(2)
#pragma unroll
  for (int r = 0; r < 16; ++r) { p0[r] = p0[r] - mn; p1[r] = p1[r] - mn; }
  PV_BLOCK(3)
#pragma unroll
  for (int r = 0; r < 16; ++r) p0[r] = __builtin_amdgcn_exp2f(p0[r]);
}

DI void attn_unit(const bf16_t* __restrict__ Qb, const bf16_t* __restrict__ Kh, const bf16_t* __restrict__ Vh, const bf16_t* __restrict__ Ph,
                  bf16_t* __restrict__ Ob, int seq, float* __restrict__ lse_out, char* lds) {
  constexpr int LDQ = 1536, LDK = 2048, LDP = 64, LDO = 1024;
  int tid = threadIdx.x; asm volatile("" : "+v"(tid));
  const int wid = tid >> 6, lane = tid & 63, r32 = lane & 31, hi = lane >> 5;
  constexpr int A_STG = 40960, A_KO = 16384, A_PO = 32768;
  float* wsf = (float*)(lds + 155648) + wid * 64; float* li_l = wsf; float* al_l = wsf + 32;
  float m_reg = -1e30f, l_reg = 0; f32x16 o[4] = {}; bf16x8 qr[8];
  char* QP = lds + 122880 + wid * 4096 + lane * 16;
  const bf16_t* Qw = Qb + (long)(wid * 32 + r32) * LDQ + hi * 8;
#pragma unroll
  for (int d0 = 0; d0 < 8; ++d0) qr[d0] = *reinterpret_cast<const bf16x8*>(Qw + d0 * 16);
#pragma unroll
  for (int d0 = 0; d0 < 4; ++d0) *reinterpret_cast<bf16x8*>(QP + d0 * 1024) = *reinterpret_cast<const bf16x8*>(Qw + 128 + d0 * 16);
  const int sr = tid >> 4, sc = (tid & 15) * 8, vst0 = v_st(sr, sc), vst1 = v_st(32 + sr, sc);
  const int pr = tid >> 3, pc = (tid & 7) * 8;
  const int vb0 = (int)(unsigned)(size_t)(LAS char*)lds + v_rd_base(lane);
  bf16x8 vs0, vs1, ks0, ks1, ps0;
#define SLOAD(k0) do { vs0 = *(const bf16x8*)(&Vh[(long)((k0) + sr) * LDK + sc]); vs1 = *(const bf16x8*)(&Vh[(long)((k0) + 32 + sr) * LDK + sc]); \
    ks0 = *(const bf16x8*)(&Kh[(long)((k0) + sr) * LDK + sc]); ks1 = *(const bf16x8*)(&Kh[(long)((k0) + 32 + sr) * LDK + sc]); \
    ps0 = *(const bf16x8*)(&Ph[(long)((k0) + pr) * LDP + pc]); } while (0)
#define SWRITE(st) do { char* b_ = lds + (st); *(bf16x8*)(b_ + vst0) = vs0; *(bf16x8*)(b_ + vst1) = vs1; const int kc = sc * 2; \
    *(bf16x8*)(b_ + A_KO + KSWZ(sr, kc)) = ks0; *(bf16x8*)(b_ + A_KO + KSWZ(32 + sr, kc)) = ks1; \
    *(bf16x8*)(b_ + A_PO + PSWZ(pr, pc * 2)) = ps0; } while (0)
#define SWAIT() asm volatile("s_waitcnt vmcnt(0)" ::: "memory")
#define RESC(a) do { if (__any((a) < 1.f)) { if (hi == 0) al_l[r32] = (a); asm volatile("s_waitcnt lgkmcnt(0)" ::: "memory"); \
    _Pragma("unroll") for (int d = 0; d < 4; ++d) _Pragma("unroll") for (int r = 0; r < 16; ++r) o[d][r] *= al_l[crow(r, hi)]; } } while (0)
  f32x16 pA0, pA1, pB0, pB1; float mnA, mnB, alA, alB; bf16x8 pa0, pa1, pa2, pa3; const int NT = seq / 64;
  SLOAD(0); SWAIT(); SWRITE(0); __syncthreads();
  a_qkt(pA0, pA1, lds + A_KO, lds + A_PO, qr, QP, r32, hi); a_partialSM(pA0, pA1, m_reg, mnA, alA);
  SLOAD(64);
  SWAIT(); SWRITE(A_STG); __syncthreads();
  int sV = 0, sK = A_STG, sW = 2 * A_STG;
  for (int j = 1; j + 1 < NT; j += 2) {
    SBAR(); a_qkt(pB0, pB1, lds + sK + A_KO, lds + sK + A_PO, qr, QP, r32, hi);
    a_finishSM(pA0, pA1, alA, l_reg, pa0, pa1, pa2, pa3); SBAR();
    SLOAD((j + 1) * 64); SBAR();
    pv_sm(o, vb0 + sV, pa0, pa1, pa2, pa3, pB0, pB1, m_reg, mnB, alB);
    SWAIT(); SWRITE(sW);
    RESC(alB); __syncthreads();
    { const int t_ = sV; sV = sK; sK = sW; sW = t_; }
    SBAR(); a_qkt(pA0, pA1, lds + sK + A_KO, lds + sK + A_PO, qr, QP, r32, hi);
    a_finishSM(pB0, pB1, alB, l_reg, pa0, pa1, pa2, pa3); SBAR();
    SLOAD((j + 2) * 64); SBAR();
    pv_sm(o, vb0 + sV, pa0, pa1, pa2, pa3, pA0, pA1, m_reg, mnA, alA);
    SWAIT(); SWRITE(sW);
    RESC(alA); __syncthreads();
    { const int t_ = sV; sV = sK; sK = sW; sW = t_; }
  }
  SBAR(); a_qkt(pB0, pB1, lds + sK + A_KO, lds + sK + A_PO, qr, QP, r32, hi);
  a_finishSM(pA0, pA1, alA, l_reg, pa0, pa1, pa2, pa3); SBAR();
  pv_sm(o, vb0 + sV, pa0, pa1, pa2, pa3, pB0, pB1, m_reg, mnB, alB);
  __syncthreads(); RESC(alB);
  a_finishSM(pB0, pB1, alB, l_reg, pa0, pa1, pa2, pa3); SBAR();
  pv_d0(o, vb0 + sK, pa0, pa1, pa2, pa3);
  if (hi == 0) li_l[r32] = l_reg; asm volatile("s_waitcnt lgkmcnt(0)" ::: "memory");
  if (lse_out != nullptr && hi == 0) lse_out[wid * 32 + r32] = m_reg + __builtin_amdgcn_logf(l_reg);
  float rli[16];
#pragma unroll
  for (int r = 0; r < 16; ++r) rli[r] = __builtin_amdgcn_rcpf(li_l[crow(r, hi)]);
  bf16_t* Ow = Ob + (long)(wid * 32) * LDO;
#pragma unroll
  for (int r = 0; r < 16; ++r) { const int orow = crow(r, hi);
#pragma unroll
    for (int d0 = 0; d0 < 4; ++d0) { const float v = o[d0][r] * rli[r]; Ow[(long)orow * LDO + d0 * 32 + r32] = (bf16_t)(pk2(v, v) & 0xffffu); } }
#undef SLOAD
#undef SWRITE
#undef SWAIT
#undef RESC
}

constexpr int G_QD = 0, G_KI = 17408, G_KT = 34816, G_VT = 53248, G_XS = 90112, G_GF = 99328, G_GT = 103424, G_DEC = 107520, G_WG = 108032, G_WGL = 114176, G_OT = 120320;
constexpr int QDS = 272, KTS = 144;
#define LBAR() do { asm volatile("s_waitcnt lgkmcnt(0)" ::: "memory"); __builtin_amdgcn_s_barrier(); asm volatile("" ::: "memory"); } while (0)
DI float logsig16(float z) { return -(fmaxf(-z, 0.f) + __logf(1.f + __expf(-fabsf(z)))) * (1.0f / 16.0f); }

DI void gla_task(const Params& p, int task, char* lds) {
  int tid = threadIdx.x; asm volatile("" : "+v"(tid));
  const int wid = __builtin_amdgcn_readfirstlane(tid >> 6), lane = tid & 63, r32_ = lane & 31, hi_ = lane >> 5;
  int seqstart, NC, sub, vh = 0; bool split = false;
  if (task < 16) { seqstart = TP; NC = 256; sub = task >> 1; vh = task & 1; split = true; } else { const int t2 = task - 16; seqstart = (t2 >> 3) * 4096; NC = 64; sub = t2 & 7; }
  const int dir = sub & 1, h = sub >> 1;
  const int dvb = split ? 4 * vh + wid : wid;
  const bool act = !split || wid < 4;
  const bf16_t* PG = (const bf16_t*)(p.ws + OFF_PROJG);
  const bf16_t* PS = (const bf16_t*)(p.ws + OFF_PROJS);
  bf16_t* OUT = (bf16_t*)(p.out + (dir ? DO_OB : DO_OF));
  const int chp = tid & 63, g = wid, c0_ = 2 * chp;
  __syncthreads();
  {
    const float* W = dir ? p.w_gk_b : p.w_gk_f;
    for (int i = tid; i < 16 * 128; i += 512) {
      const int kk = i >> 7, ch = i & 127;
      const float w = W[kk * 512 + h * 128 + ch];
      const unsigned hb = pk2(w, w) & 0xffffu;
      const float wl = w - __uint_as_float(hb << 16);
      *(short*)(lds + G_WG + ch * 48 + kk * 2) = (short)hb;
      *(short*)(lds + G_WGL + ch * 48 + kk * 2) = (short)(pk2(wl, wl) & 0xffffu);
    }
    if (tid < 64) {
      const int l15 = tid & 15, q4 = tid >> 4;
      *(u32x2*)(lds + G_XS + l15 * KTS + (16 + 4 * q4) * 2) = (u32x2){0u, 0u};
      *(u32x2*)(lds + G_XS + (32 + l15) * KTS + (48 + 4 * q4) * 2) = (u32x2){0u, 0u};
    }
  }
  const float biasm = ((dir ? p.b_gk_b : p.b_gk_f) + h * 128)[32 * (wid & 3) + r32_];
  f32x16 S[4] = {};
  const int spos_ = tid >> 3, sc8_ = (tid & 7) * 8;
  const int vsr_ = tid >> 4, vsc_ = (tid & 15) * 8;
  bf16x8 rq0, rq1, rk0, rk1, rv0, rv1, rv2, rv3, rg;
  rg = bf16x8{}; rv0 = bf16x8{}; rv1 = bf16x8{}; rv2 = bf16x8{}; rv3 = bf16x8{};
#define GLOAD(n) do { const int c_ = dir ? NC - 1 - (n) : (n); const long tok_ = (long)seqstart + c_ * 64 + (dir ? 63 - spos : spos); \
    const bf16_t* rp_ = PG + tok_ * 3072; \
    rq0 = *(const bf16x8*)(rp_ + h * 128 + sc8); rq1 = *(const bf16x8*)(rp_ + h * 128 + 64 + sc8); \
    rk0 = *(const bf16x8*)(rp_ + 512 + h * 128 + sc8); rk1 = *(const bf16x8*)(rp_ + 512 + h * 128 + 64 + sc8); \
    { const long tv0_ = (long)seqstart + c_ * 64 + (dir ? 63 - vsr : vsr), tv1_ = (long)seqstart + c_ * 64 + (dir ? 31 - vsr : 32 + vsr); \
      const bf16_t* v0_ = PG + tv0_ * 3072 + 1024 + h * 256 + vsc; const bf16_t* v1_ = PG + tv1_ * 3072 + 1024 + h * 256 + vsc; \
      if (!split || vh == 0) { rv0 = *(const bf16x8*)(v0_); rv1 = *(const bf16x8*)(v1_); } if (!split || vh == 1) { rv2 = *(const bf16x8*)(v0_ + 128); rv3 = *(const bf16x8*)(v1_ + 128); } } \
    if (tid < 128) { const long tg_ = (long)seqstart + c_ * 64 + (dir ? 63 - (tid >> 1) : (tid >> 1)); rg = *(const bf16x8*)(PS + tg_ * 256 + 64 + dir * 16 + (tid & 1) * 8); } } while (0)
#define GFL_READ() do { const int ch_ = lane_v & 3, p0_ = lane_v >> 2; \
    _Pragma("unroll") for (int e_ = 0; e_ < 4; ++e_) ow[e_] = *(const u32x4*)(lds + G_OT + wid * 4096 + (p0_ + 16 * e_) * 64 + ch_ * 16); } while (0)
#define GFL_STORE(np) do { const int c_ = dir ? NC - 1 - (np) : (np); const long tb_ = (long)seqstart + c_ * 64; \
    const int ch_ = lane_v & 3, p0_ = lane_v >> 2; \
    _Pragma("unroll") for (int e_ = 0; e_ < 4; ++e_) { const int pos_ = p0_ + 16 * e_; \
      const long t_ = tb_ + (dir ? 63 - pos_ : pos_); \
      *(u32x4*)(OUT + t_ * 1024 + h * 256 + 32 * dvb + ch_ * 8) = ow[e_]; } } while (0)
  u32x4 ow[4] = {};
  { const int spos = spos_, sc8 = sc8_, vsr = vsr_, vsc = vsc_; GLOAD(0); }
  for (int n = 0; n < NC; ++n) {
    int tidv = tid; asm volatile("" : "+v"(tidv));
    const int lanev = tidv & 63, r32 = lanev & 31, hi = lanev >> 5, c0 = 2 * lanev, spos = tidv >> 3, sc8 = (tidv & 7) * 8, vsr = tidv >> 4, vsc = (tidv & 15) * 8;
    if (tid < 128) *(bf16x8*)(lds + G_GF + (tid >> 1) * 48 + (tid & 1) * 16) = rg;
    { const int lane_v = r32 | (hi << 5); if (n > 0 && act) GFL_READ(); }
    LBAR();
    {
      const int tm = wid >> 2, tn = wid & 3;
      const bf16x8 ga = *(const bf16x8*)(lds + G_GF + (32 * tm + r32) * 48 + hi * 16);
      const bf16x8 bh = *(const bf16x8*)(lds + G_WG + (32 * tn + r32) * 48 + hi * 16);
      const bf16x8 bl = *(const bf16x8*)(lds + G_WGL + (32 * tn + r32) * 48 + hi * 16);
      f32x16 z = {};
      z = MFMA32(ga, bh, z); z = MFMA32(ga, bl, z);
      float* zl = (float*)(lds + G_OT) + (32 * tm + 4 * hi) * 128 + 32 * tn + r32;
#pragma unroll
      for (int r = 0; r < 16; ++r) {
        const float zz = z[r] + biasm;
        const float e = __builtin_amdgcn_exp2f(fabsf(zz) * -1.4426950408889634f);
        const float l = __builtin_amdgcn_logf(1.f + e);
        zl[((r & 3) + 8 * (r >> 2)) * 128] = (fminf(zz, 0.f) * 1.4426950408889634f - l) * 0.0625f;
      }
    }
    LBAR();
    *(bf16x8*)(lds + G_QD + spos * QDS + sc8 * 2) = rq0; *(bf16x8*)(lds + G_QD + spos * QDS + (sc8 + 64) * 2) = rq1;
    *(bf16x8*)(lds + G_KI + spos * QDS + sc8 * 2) = rk0; *(bf16x8*)(lds + G_KI + spos * QDS + (sc8 + 64) * 2) = rk1;
    *(bf16x8*)(lds + G_VT + v_st(vsr, vsc)) = rv0; *(bf16x8*)(lds + G_VT + v_st(32 + vsr, vsc)) = rv1;
    *(bf16x8*)(lds + G_VT + 16384 + v_st(vsr, vsc)) = rv2; *(bf16x8*)(lds + G_VT + 16384 + v_st(32 + vsr, vsc)) = rv3;
    { const int lane_v = r32 | (hi << 5); if (n > 0 && act) GFL_STORE(n - 1); }
    if (n + 1 < NC) GLOAD(n + 1);
    float bl0[8], bl1[8];
    {
      float run0 = 0.f, run1 = 0.f;
#pragma unroll
      for (int r = 0; r < 8; ++r) {
        const f32x2 t = *(const f32x2*)((const float*)(lds + G_OT) + (8 * g + r) * 128 + c0);
        run0 += t[0]; run1 += t[1]; bl0[r] = run0; bl1[r] = run1;
      }
      *(f32x2*)((float*)(lds + G_GT) + g * 128 + c0) = (f32x2){run0, run1};
    }
    LBAR();
    {
      float pre0 = 0.f, pre1 = 0.f, all0 = 0.f, all1 = 0.f;
#pragma unroll
      for (int gg = 0; gg < 8; ++gg) { const f32x2 t = *(const f32x2*)((const float*)(lds + G_GT) + gg * 128 + c0);
        all0 += t[0]; all1 += t[1]; if (gg < g) { pre0 += t[0]; pre1 += t[1]; } }
      const float ea0 = __builtin_amdgcn_exp2f(all0), ea1 = __builtin_amdgcn_exp2f(all1);
      float kt0[8], kt1[8];
#pragma unroll
      for (int r = 0; r < 8; ++r) {
        const float e0 = __builtin_amdgcn_exp2f(pre0 + bl0[r]), e1 = __builtin_amdgcn_exp2f(pre1 + bl1[r]);
        const float i0 = __builtin_amdgcn_rcpf(e0), i1 = __builtin_amdgcn_rcpf(e1);
        unsigned* qp = (unsigned*)(lds + G_QD + (8 * g + r) * QDS + c0 * 2);
        unsigned* kp = (unsigned*)(lds + G_KI + (8 * g + r) * QDS + c0 * 2);
        const unsigned qw = *qp, kw = *kp;
        const float k0 = bflo(kw) * i0, k1 = bfhi(kw) * i1;
        *qp = pk2(bflo(qw) * GLA_QS * e0, bfhi(qw) * GLA_QS * e1);
        *kp = pk2(k0, k1);
        kt0[r] = k0 * ea0; kt1[r] = k1 * ea1;
      }
      u32x4 w0 = {pk2(kt0[0], kt0[1]), pk2(kt0[2], kt0[3]), pk2(kt0[4], kt0[5]), pk2(kt0[6], kt0[7])};
      u32x4 w1 = {pk2(kt1[0], kt1[1]), pk2(kt1[2], kt1[3]), pk2(kt1[4], kt1[5]), pk2(kt1[6], kt1[7])};
      *(u32x4*)(lds + G_KT + c0 * KTS + g * 16) = w0;
      *(u32x4*)(lds + G_KT + (c0 + 1) * KTS + g * 16) = w1;
      if (g == 0) *(f32x2*)((float*)(lds + G_DEC) + c0) = (f32x2){ea0, ea1};
    }
    LBAR();
    {
      const int l15 = lane & 15, q4 = lane >> 4;
#pragma unroll
      for (int rep = 0; rep < 2; ++rep) {
        const int idx = wid + 8 * rep;
        if (idx < 10) {
          int a, bb;
          if (idx < 4) { a = idx; bb = idx; } else if (idx < 7) { a = 0; bb = idx - 3; } else if (idx < 9) { a = 1; bb = idx - 5; } else { a = 2; bb = 3; }
          const char* kb = lds + G_KI + (16 * a + l15) * QDS + q4 * 16;
          const char* qb = lds + G_QD + (16 * bb + l15) * QDS + q4 * 16;
          f32x4 acc = {0.f, 0.f, 0.f, 0.f};
#pragma unroll
          for (int kk = 0; kk < 4; ++kk)
            acc = __builtin_amdgcn_mfma_f32_16x16x32_bf16(*(const bf16x8*)(kb + kk * 64), *(const bf16x8*)(qb + kk * 64), acc, 0, 0, 0);
          if (a == bb) {
#pragma unroll
            for (int r = 0; r < 4; ++r) if (4 * q4 + r > l15) acc[r] = 0.f;
          }
          *(u32x2*)(lds + G_XS + (16 * bb + l15) * KTS + (16 * a + 4 * q4) * 2) = (u32x2){pk2(acc[0], acc[1]), pk2(acc[2], acc[3])};
        }
      }
    }
    LBAR();
    if (act) {
    f32x16 O0 = {}, O1 = {};
    {
      bf16x8 vb[4];
      {
        const int vbase = (int)(unsigned)(size_t)(LAS char*)(lds + G_VT) + (dvb >> 2) * 16384 + (dvb & 3) * 512 + v_rd_base(r32 | (hi << 5));
        const s16x4 l0 = tr_read<v_rd_off(0, 0, 0)>(vbase), h0 = tr_read<v_rd_off(0, 0, 1)>(vbase), l1 = tr_read<v_rd_off(0, 1, 0)>(vbase), h1 = tr_read<v_rd_off(0, 1, 1)>(vbase);
        const s16x4 l2 = tr_read<v_rd_off(0, 2, 0)>(vbase), h2 = tr_read<v_rd_off(0, 2, 1)>(vbase), l3 = tr_read<v_rd_off(0, 3, 0)>(vbase), h3 = tr_read<v_rd_off(0, 3, 1)>(vbase);
        asm volatile("s_waitcnt lgkmcnt(0)" ::: "memory"); SBAR();
        vb[0] = (bf16x8){l0[0], l0[1], l0[2], l0[3], h0[0], h0[1], h0[2], h0[3]};
        vb[1] = (bf16x8){l1[0], l1[1], l1[2], l1[3], h1[0], h1[1], h1[2], h1[3]};
        vb[2] = (bf16x8){l2[0], l2[1], l2[2], l2[3], h2[0], h2[1], h2[2], h2[3]};
        vb[3] = (bf16x8){l3[0], l3[1], l3[2], l3[3], h3[0], h3[1], h3[2], h3[3]};
      }
      const char* xa0 = lds + G_XS + r32 * KTS + hi * 16;
      const char* xa1 = lds + G_XS + (32 + r32) * KTS + hi * 16;
#pragma unroll
      for (int ks = 0; ks < 2; ++ks) O0 = MFMA32(*(const bf16x8*)(xa0 + ks * 32), vb[ks], O0);
#pragma unroll
      for (int ks = 0; ks < 4; ++ks) O1 = MFMA32(*(const bf16x8*)(xa1 + ks * 32), vb[ks], O1);
#pragma unroll
      for (int dkb = 0; dkb < 4; ++dkb) {
#pragma unroll
        for (int s = 0; s < 2; ++s) {
          const bf16x8 xs = pack8(S[dkb], s);
          const char* qa = lds + G_QD + r32 * QDS + (32 * dkb + 16 * s) * 2 + hi * 8;
          {
            const s16x4 lo = *(const s16x4*)(qa), hh = *(const s16x4*)(qa + 16);
            const bf16x8 pa = {lo[0], lo[1], lo[2], lo[3], hh[0], hh[1], hh[2], hh[3]};
            O0 = MFMA32(pa, xs, O0);
          }
          {
            const s16x4 lo = *(const s16x4*)(qa + 32 * QDS), hh = *(const s16x4*)(qa + 32 * QDS + 16);
            const bf16x8 pa = {lo[0], lo[1], lo[2], lo[3], hh[0], hh[1], hh[2], hh[3]};
            O1 = MFMA32(pa, xs, O1);
          }
        }
      }
      const float* dec = (const float*)(lds + G_DEC);
#pragma unroll
      for (int dkb = 0; dkb < 4; ++dkb) {
#pragma unroll
        for (int q4 = 0; q4 < 4; ++q4) {
          const f32x4 d0 = *(const f32x4*)(dec + 32 * dkb + 8 * q4 + 4 * hi);
#pragma unroll
          for (int j = 0; j < 4; ++j) S[dkb][4 * q4 + j] *= d0[j];
        }
        const char* ka = lds + G_KT + (32 * dkb + r32) * KTS + hi * 16;
#pragma unroll
        for (int ks = 0; ks < 4; ++ks) S[dkb] = MFMA32(*(const bf16x8*)(ka + ks * 32), vb[ks], S[dkb]);
      }
    }
    {
      char* ot = lds + G_OT + wid * 4096 + r32 * 2;
#pragma unroll
      for (int r = 0; r < 16; ++r) {
        const int i0 = crow(r, hi);
        *(short*)(ot + i0 * 64) = (short)(pk2(O0[r], O0[r]) & 0xffffu);
        *(short*)(ot + (32 + i0) * 64) = (short)(pk2(O1[r], O1[r]) & 0xffffu);
      }
    }
    }
  }
  if (act) { const int lane_v = lane; GFL_READ(); GFL_STORE(NC - 1); }
#undef GLOAD
#undef GFL_READ
#undef GFL_STORE
}

DI void phase_kpe(const Params& p) {
  const bf16_t* PS = (const bf16_t*)(p.ws + OFF_PROJS);
  unsigned* KPE = (unsigned*)(p.ws + OFF_KPE);
  const f32x2* tab = (const f32x2*)(p.ws + OFF_ROPE);
  const int stride = gridDim.x * 512;
  for (int idx0 = blockIdx.x * 512 + threadIdx.x; idx0 < T * 32; idx0 += 8 * stride) {
    float k1[8], k2[8]; f32x2 cs[8];
#pragma unroll
    for (int k = 0; k < 8; ++k) { const int idx = idx0 + k * stride; k1[k] = 0.f; k2[k] = 0.f; cs[k] = (f32x2){0.f, 0.f};
      if (idx < T * 32) { const int tok = idx >> 5, i = idx & 31; const int pos = tok < TP ? (tok & 4095) : tok - TP;
        k1[k] = bf2f((short)PS[(size_t)tok * 256 + i]); k2[k] = bf2f((short)PS[(size_t)tok * 256 + 32 + i]); cs[k] = tab[pos * 32 + i]; } }
#pragma unroll
    for (int k = 0; k < 8; ++k) { const int idx = idx0 + k * stride;
      if (idx < T * 32) KPE[idx] = pk2(k1[k] * cs[k][0] - k2[k] * cs[k][1], k2[k] * cs[k][0] + k1[k] * cs[k][1]); }
  }
}
DI void phase_e0(const Params& p) {
  const int tid = threadIdx.x, lane = tid & 63;
  const bf16_t* PG = (const bf16_t*)(p.ws + OFF_PROJG);
  bf16_t* OF = (bf16_t*)(p.out + DO_OF); const bf16_t* OBk = (const bf16_t*)(p.out + DO_OB);
  const int gw = blockIdx.x * 8 + (tid >> 6), nw = gridDim.x * 8;
  float gn[16];
#pragma unroll
  for (int j = 0; j < 16; ++j) gn[j] = p.gla_norm[(lane & 15) * 16 + j];
  for (int row0 = gw; row0 < T; row0 += 4 * nw) {
    u32x4 xa[4][2], ya[4][2], za[4][2];
#pragma unroll
    for (int k = 0; k < 4; ++k) { const size_t row = (size_t)row0 + (size_t)k * nw;
      const u32x4* a = (const u32x4*)(OF + row * 1024 + lane * 16);
      const u32x4* b = (const u32x4*)(OBk + row * 1024 + lane * 16);
      const u32x4* gp = (const u32x4*)(PG + row * 3072 + 2048 + lane * 16);
#pragma unroll
      for (int q = 0; q < 2; ++q) { xa[k][q] = __builtin_nontemporal_load(a + q); ya[k][q] = __builtin_nontemporal_load(b + q); za[k][q] = __builtin_nontemporal_load(gp + q); } }
#pragma unroll
    for (int k = 0; k < 4; ++k) { const size_t row = (size_t)row0 + (size_t)k * nw;
      float v[16], gg[16];
#pragma unroll
      for (int q = 0; q < 2; ++q)
#pragma unroll
        for (int j = 0; j < 4; ++j) { v[q * 8 + 2 * j] = bflo(xa[k][q][j]) + bflo(ya[k][q][j]); v[q * 8 + 2 * j + 1] = bfhi(xa[k][q][j]) + bfhi(ya[k][q][j]);
          gg[q * 8 + 2 * j] = bflo(za[k][q][j]); gg[q * 8 + 2 * j + 1] = bfhi(za[k][q][j]); }
      float ss = 0.f;
#pragma unroll
      for (int j = 0; j < 16; ++j) ss += v[j] * v[j];
      ss += __shfl_xor(ss, 1); ss += __shfl_xor(ss, 2); ss += __shfl_xor(ss, 4); ss += __shfl_xor(ss, 8);
      const float rs = __builtin_amdgcn_rsqf(ss * (1.0f / 256) + EPS);
      float o[16];
#pragma unroll
      for (int j = 0; j < 16; ++j) { const float sg = gg[j] / (1.f + __expf(-gg[j])); o[j] = v[j] * rs * gn[j] * sg; }
      u32x4 w0 = {pk2(o[0], o[1]), pk2(o[2], o[3]), pk2(o[4], o[5]), pk2(o[6], o[7])};
      u32x4 w1 = {pk2(o[8], o[9]), pk2(o[10], o[11]), pk2(o[12], o[13]), pk2(o[14], o[15])};
      u32x4* d = (u32x4*)(OF + row * 1024 + lane * 16);
      d[0] = w0; d[1] = w1; }
  }
}
DI void phase_combine(const Params& p) {
  const int tid = threadIdx.x, lane = tid & 63;
  bf16_t* MO = (bf16_t*)(p.ws + OFF_PROJA);
  const bf16_t* P1 = (const bf16_t*)(p.out + DO_P1);
  const float* L0 = (const float*)(p.out + DO_LSE); const float* L1 = L0 + 8 * N_SSPLIT * 256;
  const int gw = blockIdx.x * 8 + (tid >> 6), nw = gridDim.x * 8;
  constexpr int NJ = 8 * N_SSPLIT * 256;
  for (int j0 = gw; j0 < NJ; j0 += 4 * nw) {
    float l0[4], l1[4]; unsigned a[4], b[4]; unsigned* d[4];
#pragma unroll
    for (int k = 0; k < 4; ++k) { const int j = j0 + k * nw; d[k] = nullptr; l0[k] = 0.f; l1[k] = 0.f; a[k] = 0u; b[k] = 0u;
      if (j < NJ) { const int si = j >> 8, h = si / N_SSPLIT, blk = 64 - N_SSPLIT + (si % N_SSPLIT);
        const long row = (long)TP + blk * 256 + (j & 255);
        l0[k] = L0[j]; l1[k] = L1[j];
        d[k] = (unsigned*)(MO + row * 1024 + h * 128) + lane;
        a[k] = *d[k]; b[k] = ((const unsigned*)(P1 + (long)j * 1024))[lane]; } }
#pragma unroll
    for (int k = 0; k < 4; ++k) if (d[k] != nullptr) {
      const float m = fmaxf(l0[k], l1[k]);
      const float w0 = __builtin_amdgcn_exp2f(l0[k] - m), w1 = __builtin_amdgcn_exp2f(l1[k] - m), inv = __builtin_amdgcn_rcpf(w0 + w1);
      *d[k] = pk2((w0 * bflo(a[k]) + w1 * bflo(b[k])) * inv, (w0 * bfhi(a[k]) + w1 * bfhi(b[k])) * inv); }
  }
}
DI void phase_e1(const Params& p) {
  const int tid = threadIdx.x, lane = tid & 63;
  const bf16_t* MIX = (const bf16_t*)(p.ws + OFF_MIX);
  bf16_t* XB1 = (bf16_t*)(p.ws + OFF_XB);
  float* X1 = (float*)p.out; float* rs2 = (float*)(p.ws + OFF_RS2);
  const float* ssqm = (const float*)(p.ws + OFF_SSQM);
  const int gw = blockIdx.x * 8 + (tid >> 6), nw = gridDim.x * 8;
  f32x4 gv[8];
#pragma unroll
  for (int i = 0; i < 8; ++i) gv[i] = *(const f32x4*)(p.post_mix + (i * 64 + lane) * 4);
  for (int row0 = gw; row0 < T; row0 += 2 * nw) {
    const int row1 = row0 + nw;
    const float* src0 = row0 < TP ? p.x0 + (size_t)row0 * DM : p.x1 + (size_t)(row0 - TP) * DM;
    const float* src1 = row1 < TP ? p.x0 + (size_t)row1 * DM : p.x1 + (size_t)(row1 - TP) * DM;
    float sp0 = lane < 32 ? ssqm[(size_t)row0 * 32 + lane] : 0.f, sp1 = lane < 32 ? ssqm[(size_t)row1 * 32 + lane] : 0.f;
    f32x4 xa[8], xb[8]; u32x2 ma[8], mb[8];
#pragma unroll
    for (int i = 0; i < 8; ++i) { const int c = (i * 64 + lane) * 4;
      xa[i] = __builtin_nontemporal_load((const f32x4*)(src0 + c)); ma[i] = __builtin_nontemporal_load((const u32x2*)(MIX + (size_t)row0 * DM + c));
      xb[i] = __builtin_nontemporal_load((const f32x4*)(src1 + c)); mb[i] = __builtin_nontemporal_load((const u32x2*)(MIX + (size_t)row1 * DM + c)); }
    sp0 = wave_sum(sp0); sp1 = wave_sum(sp1);
    const float ra = __builtin_amdgcn_rsqf(sp0 * (1.0f / DM) + EPS), rb = __builtin_amdgcn_rsqf(sp1 * (1.0f / DM) + EPS);
    float sa = 0.f, sb = 0.f;
#pragma unroll
    for (int i = 0; i < 8; ++i) { const int c = (i * 64 + lane) * 4;
      f32x4 y, z;
      y[0] = xa[i][0] + bflo(ma[i][0]) * ra * gv[i][0]; y[1] = xa[i][1] + bfhi(ma[i][0]) * ra * gv[i][1];
      y[2] = xa[i][2] + bflo(ma[i][1]) * ra * gv[i][2]; y[3] = xa[i][3] + bfhi(ma[i][1]) * ra * gv[i][3];
      z[0] = xb[i][0] + bflo(mb[i][0]) * rb * gv[i][0]; z[1] = xb[i][1] + bfhi(mb[i][0]) * rb * gv[i][1];
      z[2] = xb[i][2] + bflo(mb[i][1]) * rb * gv[i][2]; z[3] = xb[i][3] + bfhi(mb[i][1]) * rb * gv[i][3];
      sa += y[0] * y[0] + y[1] * y[1] + y[2] * y[2] + y[3] * y[3];
      sb += z[0] * z[0] + z[1] * z[1] + z[2] * z[2] + z[3] * z[3];
      u32x2 w0 = {pk2(y[0], y[1]), pk2(y[2], y[3])}, w1 = {pk2(z[0], z[1]), pk2(z[2], z[3])};
      *(u32x2*)(XB1 + (size_t)row0 * DM + c) = w0; *(u32x2*)(XB1 + (size_t)row1 * DM + c) = w1; }
    sa = wave_sum(sa); sb = wave_sum(sb);
    if (lane == 0) { rs2[row0] = __builtin_amdgcn_rsqf(sa * (1.0f / DM) + EPS); rs2[row1] = __builtin_amdgcn_rsqf(sb * (1.0f / DM) + EPS); }
  }
}
DI void phase_e2(const Params& p) {
  const int tid = threadIdx.x, lane = tid & 63;
  const bf16_t* XB1 = (const bf16_t*)(p.ws + OFF_XB);
  float* OUT = (float*)p.out;
  const float* ssqm = (const float*)(p.ws + OFF_SSQM);
  const int gw = blockIdx.x * 8 + (tid >> 6), nw = gridDim.x * 8;
  f32x4 gv[8];
#pragma unroll
  for (int i = 0; i < 8; ++i) gv[i] = *(const f32x4*)(p.post_mlp + (i * 64 + lane) * 4);
  for (int row0 = gw; row0 < T; row0 += 2 * nw) {
    const int row1 = row0 + nw;
    float sp0 = lane < 32 ? ssqm[(size_t)row0 * 32 + lane] : 0.f, sp1 = lane < 32 ? ssqm[(size_t)row1 * 32 + lane] : 0.f;
    u32x2 xa[8], xb[8], fa[8], fb[8];
#pragma unroll
    for (int i = 0; i < 8; ++i) { const int c = (i * 64 + lane) * 4;
      xa[i] = __builtin_nontemporal_load((const u32x2*)(XB1 + (size_t)row0 * DM + c)); fa[i] = __builtin_nontemporal_load((const u32x2*)((const bf16_t*)(OUT + (size_t)row0 * DM) + c));
      xb[i] = __builtin_nontemporal_load((const u32x2*)(XB1 + (size_t)row1 * DM + c)); fb[i] = __builtin_nontemporal_load((const u32x2*)((const bf16_t*)(OUT + (size_t)row1 * DM) + c)); }
    sp0 = wave_sum(sp0); sp1 = wave_sum(sp1);
    const float ra = __builtin_amdgcn_rsqf(sp0 * (1.0f / DM) + EPS), rb = __builtin_amdgcn_rsqf(sp1 * (1.0f / DM) + EPS);
    f32x4 ya[8], yb[8];
#pragma unroll
    for (int i = 0; i < 8; ++i) {
      ya[i][0] = bflo(xa[i][0]) + bflo(fa[i][0]) * ra * gv[i][0]; ya[i][1] = bfhi(xa[i][0]) + bfhi(fa[i][0]) * ra * gv[i][1];
      ya[i][2] = bflo(xa[i][1]) + bflo(fa[i][1]) * ra * gv[i][2]; ya[i][3] = bfhi(xa[i][1]) + bfhi(fa[i][1]) * ra * gv[i][3];
      yb[i][0] = bflo(xb[i][0]) + bflo(fb[i][0]) * rb * gv[i][0]; yb[i][1] = bfhi(xb[i][0]) + bfhi(fb[i][0]) * rb * gv[i][1];
      yb[i][2] = bflo(xb[i][1]) + bflo(fb[i][1]) * rb * gv[i][2]; yb[i][3] = bfhi(xb[i][1]) + bfhi(fb[i][1]) * rb * gv[i][3]; }
    asm volatile("s_waitcnt vmcnt(0)" ::: "memory");
#pragma unroll
    for (int i = 0; i < 8; ++i) { const int c = (i * 64 + lane) * 4;
      __builtin_nontemporal_store(ya[i], (f32x4*)(OUT + (size_t)row0 * DM + c)); __builtin_nontemporal_store(yb[i], (f32x4*)(OUT + (size_t)row1 * DM + c)); }
  }
}

DI void phase_mixer(const Params& p, char* lds) {
  unsigned* ctr = (unsigned*)(p.ws + OFF_CTR);
  int* sh = (int*)(lds + 157696);
  const bf16_t* Q = (const bf16_t*)(p.out + DO_Q);
  const bf16_t* KV = (const bf16_t*)(p.ws + OFF_XB);
  const bf16_t* KPE = (const bf16_t*)(p.ws + OFF_KPE);
  bf16_t* MO = (bf16_t*)(p.ws + OFF_PROJA);
  const int xcd = blockIdx.x & 7;
  for (int d = 0; d < 8; ++d) {
    const int y = (xcd + d) & 7;
    for (;;) {
      __syncthreads();
      if (threadIdx.x == 0) *sh = (int)atomicAdd(ctr + 32 * y, 1u);
      __syncthreads();
      const int v = *sh;
      if (v >= 6) break;
#ifndef NO_GLA
      gla_task(p, v < 2 ? 2 * y + v : 16 + 4 * y + (v - 2), lds);
#endif
    }
  }
  for (int d = 0; d < 8; ++d) {
    const int y = (xcd + d) & 7;
    for (;;) {
      __syncthreads();
      if (threadIdx.x == 0) *sh = (int)atomicAdd(ctr + 256 + 32 * y, 1u);
      __syncthreads();
      const int v = *sh;
      if (v >= N_ATTQ) break;
      int seqstart, len, blk, kbeg = 0; float* lse = nullptr; const int h = y;
      bf16_t* ob = nullptr;
      if (v < 64 - N_SSPLIT) { seqstart = TP; len = 16384; blk = v; }
      else if (v < 64 + N_SSPLIT) {
        const int w = v - (64 - N_SSPLIT), i = w >> 1, half = w & 1, si = y * N_SSPLIT + i;
        seqstart = TP; len = 8192; kbeg = half * 8192; blk = 64 - N_SSPLIT + i;
        lse = (float*)(p.out + DO_LSE) + half * (8 * N_SSPLIT * 256) + si * 256;
        if (half) ob = (bf16_t*)(p.out + DO_P1) + (long)si * 256 * 1024;
      } else { const int v2 = v - (64 + N_SSPLIT); seqstart = (v2 >> 4) * 4096; len = 4096; blk = v2 & 15; }
      const long q0 = (long)seqstart + blk * 256, k0 = (long)seqstart + kbeg;
      if (ob == nullptr) ob = MO + q0 * 1024 + h * 128;
#ifndef NO_ATT
      attn_unit(Q + q0 * 1536 + h * 192, KV + k0 * 2048 + h * 256, KV + k0 * 2048 + h * 256 + 128, KPE + k0 * 64, ob, len, lse, lds);
#endif
    }
  }
  for (;;) {
    __syncthreads();
    if (threadIdx.x == 0) *sh = (int)atomicAdd(ctr + 512, 4u);
    __syncthreads();
    const int t0 = *sh;
    if (t0 >= N_LATE) break;
    conv_late_tile4(p, t0, lds);
  }
}

DI void gbar(unsigned* bar, unsigned k, char* lds) {
  asm volatile("s_waitcnt vmcnt(0)" ::: "memory");
  __syncthreads();
  if (threadIdx.x == 0) {
    volatile unsigned* st = (volatile unsigned*)(lds + 157696 + 64);
    const unsigned x = (unsigned)__builtin_amdgcn_s_getreg((3 << 11) | 20) & 0xFu;
    unsigned nloc, nx;
    if (k == 1u) {
      unsigned spins = 0;
      for (;;) {
        unsigned sum = 0, cnt = 0, mine = 0;
        for (unsigned j = 0; j < 16; ++j) { const unsigned c = __hip_atomic_load(bar + 2048 + 64 * j, __ATOMIC_RELAXED, __HIP_MEMORY_SCOPE_AGENT); sum += c; cnt += c ? 1u : 0u; mine = j == x ? c : mine; }
        nloc = mine ? mine : 1u; nx = cnt ? cnt : 1u;
        if (sum == gridDim.x || ++spins > (1u << 20)) break;
        __builtin_amdgcn_s_sleep(1);
      }
      st[0] = nloc; st[1] = nx;
    } else { nloc = st[0]; nx = st[1]; }
    const unsigned old = __hip_atomic_fetch_add(bar + 128 + 64 * x, 1u, __ATOMIC_RELAXED, __HIP_MEMORY_SCOPE_AGENT);
    if (old + 1u == k * nloc) {
      __builtin_amdgcn_fence(__ATOMIC_RELEASE, "agent");
      asm volatile("s_waitcnt vmcnt(0)" ::: "memory");
      const unsigned og = __hip_atomic_fetch_add(bar, 1u, __ATOMIC_RELAXED, __HIP_MEMORY_SCOPE_AGENT);
      if (og + 1u == k * nx) __hip_atomic_store(bar + 64, k, __ATOMIC_RELAXED, __HIP_MEMORY_SCOPE_AGENT);
    }
    { unsigned spins = 0; while (__hip_atomic_load(bar + 64, __ATOMIC_RELAXED, __HIP_MEMORY_SCOPE_AGENT) < k) { __builtin_amdgcn_s_sleep(1); if (++spins > (1u << 22)) break; } }
    __builtin_amdgcn_fence(__ATOMIC_ACQUIRE, "agent");
    asm volatile("s_waitcnt vmcnt(0)" ::: "memory");
  }
  __syncthreads();
}

__global__ void __launch_bounds__(512) mega(Params p, int ph_lo, int ph_hi) {
  extern __shared__ __attribute__((aligned(16))) char lds[];
  cg::grid_group grid = cg::this_grid();
#ifndef PH_MASK
#define PH_MASK 0xfff
#endif
#define PHASE(k, ...) if (((PH_MASK >> k) & 1) && ph_lo <= k && k < ph_hi) { if (k == 1) { grid.sync(); if (threadIdx.x == 0) __hip_atomic_fetch_add((unsigned*)(p.ws + OFF_CTR) + 1024 + 2048 + 64 * ((unsigned)__builtin_amdgcn_s_getreg((3 << 11) | 20) & 0xFu), 1u, __ATOMIC_RELAXED, __HIP_MEMORY_SCOPE_AGENT); } else if (k > 1) gbar((unsigned*)(p.ws + OFF_CTR) + 1024, (unsigned)(k - 1), lds); __VA_ARGS__; }
  PHASE(0, phase0(p, lds))
  PHASE(1, run_gemm<EP_IN>(p, lds, (const bf16_t*)(p.ws + OFF_XB), 2048, (const bf16_t*)(p.ws + OFF_WIN), T, NIN_PAD, 2048, 0); conv_idle_round(p, lds))
  PHASE(2, phase_kpe(p); run_gemm<EP_Q>(p, lds, (const bf16_t*)(p.ws + OFF_PROJA), 1024, (const bf16_t*)(p.ws + OFF_WQB), T, 1536, 512, 0);
           run_gemm<EP_KV>(p, lds, (const bf16_t*)(p.ws + OFF_PROJA) + 512, 1024, (const bf16_t*)(p.ws + OFF_WKVB), T, 2048, 512, 0))
  PHASE(3, phase_mixer(p, lds))
  PHASE(4, phase_combine(p); phase_e0(p))
  PHASE(5, run_gemm<EP_MIX>(p, lds, (const bf16_t*)(p.ws + OFF_PROJA), 1024, (const bf16_t*)(p.ws + OFF_WOUT), T, 2048, 2048, 0,
                            (long)((p.out + DO_OF) - (p.ws + OFF_PROJA)) - 2048, 16))
  PHASE(6, phase_e1(p))
  PHASE(7, run_gemm<EP_UP>(p, lds, (const bf16_t*)(p.ws + OFF_XB), 2048, (const bf16_t*)(p.ws + OFF_WUP), TP, DFF, 2048, 0))
  PHASE(8, run_gemm<EP_DOWN>(p, lds, (const bf16_t*)(p.ws + OFF_U), 8192, (const bf16_t*)(p.ws + OFF_WDOWN), TP, 2048, 8192, 0))
  PHASE(9, run_gemm<EP_UP>(p, lds, (const bf16_t*)(p.ws + OFF_XB) + (size_t)TP * 2048, 2048, (const bf16_t*)(p.ws + OFF_WUP), TP, DFF, 2048, TP))
  PHASE(10, run_gemm<EP_DOWN>(p, lds, (const bf16_t*)(p.ws + OFF_U), 8192, (const bf16_t*)(p.ws + OFF_WDOWN), TP, 2048, 8192, TP))
  PHASE(11, phase_e2(p))
}

extern "C" void kernel_launch(void* const* d_in, const int* in_sizes, int n_in, void* d_out, int out_size,
                              void* d_ws, size_t ws_size, hipStream_t stream) {
  static int grid_blocks = 0;
  if (!grid_blocks) {
    if (hipFuncSetAttribute((const void*)mega, hipFuncAttributeMaxDynamicSharedMemorySize, LDS_BYTES) != hipSuccess) fprintf(stderr, "set attr failed\n");
    int dev = 0, cus = 0, per_cu = 0;
    (void)hipGetDevice(&dev);
    (void)hipDeviceGetAttribute(&cus, hipDeviceAttributeMultiprocessorCount, dev);
    (void)hipOccupancyMaxActiveBlocksPerMultiprocessor(&per_cu, mega, 512, LDS_BYTES);
    if (per_cu < 1) { fprintf(stderr, "occupancy query returned %d\n", per_cu); per_cu = 1; }
    grid_blocks = cus;
  }
  if (n_in != 19 || ws_size < WS_NEED || out_size != T * DM) { fprintf(stderr, "kernel_launch: unexpected sizes n_in %d ws %zu out %d\n", n_in, ws_size, out_size); return; }
  Params p{};
  const float** pp = (const float**)&p;
  for (int i = 0; i < 19; ++i) pp[i] = (const float*)d_in[i];
  p.out = (char*)d_out; p.ws = (char*)d_ws;
  int lo = 0, hi = 12;
  void* args[] = {&p, &lo, &hi};
  hipError_t e = hipLaunchCooperativeKernel((void*)mega, dim3(grid_blocks), dim3(512), args, LDS_BYTES, stream);
  if (e != hipSuccess) fprintf(stderr, "cooperative launch failed: %s (grid %d)\n", hipGetErrorString(e), grid_blocks);
}
```
